# Optimizing an MI355X kernel written in HIP

```python
import jax, jax.numpy as jnp
from jax import lax
import numpy as np

D_MODEL = 1024
BATCH = 1
SEQ = 16384
DEPTH = 4

GRID_W = 64
CTX_LEN = 256
NA_HEADS = 8
NA_HEAD_DIM = 64
NA_KH = 8
NA_KW = 16
NA_W = NA_HEADS * NA_HEAD_DIM
MLA_HEADS = 8
MLA_NOPE = 64
MLA_ROPE = 32
MLA_V = 64
MLA_Q_LORA = 256
MLA_KV_LORA = 128
MLA_OUT_W = MLA_HEADS * MLA_V
ROPE_THETA = 10000.0
Q_BLOCK = 128
MIX_W = NA_W + MLA_OUT_W
IN_COLS = 3 * NA_W + MLA_Q_LORA + MLA_KV_LORA + MLA_ROPE
SPLITS = [NA_W, 2 * NA_W, 3 * NA_W, 3 * NA_W + MLA_Q_LORA, 3 * NA_W + MLA_Q_LORA + MLA_KV_LORA]
POOL_WINDOWS = (2, 4, 8, 16)
POOL_GROUPS = len(POOL_WINDOWS)
POOL_GROUP = D_MODEL // POOL_GROUPS
FFN_DIM = 2816
N_EXPERTS = 8
TOP_K = 2
EXPERT_DIM = 3584
N_ATTN_LAYERS = (DEPTH + 1) // 2
N_POOL_LAYERS = DEPTH // 2
DEEPNORM_ALPHA = (2 * DEPTH) ** 0.25
DEEPNORM_BETA = (8 * DEPTH) ** -0.25
LN_EPS = 1e-5
RMS_EPS = 1e-6

kernel_name = 'hybrid_na_mla_pool_moe_trunk'


def layer_norm(x, g, b):
    xf = x.astype(jnp.float32)
    mu = jnp.mean(xf, -1, keepdims=True)
    var = jnp.mean(jnp.square(xf - mu), -1, keepdims=True)
    return ((xf - mu) * lax.rsqrt(var + LN_EPS)).astype(x.dtype) * g + b


def rms_norm(x, g):
    xf = x.astype(jnp.float32)
    return (xf * lax.rsqrt(jnp.mean(xf * xf, -1, keepdims=True) + RMS_EPS)).astype(x.dtype) * g


def modulate(h, shift, scale):
    return h * (1 + scale) + shift


def softmax_f32(s, like):
    return jax.nn.softmax(s.astype(jnp.float32), axis=-1).astype(like.dtype)


def _rotate(x, ang):
    half = x.shape[-1] // 2
    x1, x2 = x[..., :half], x[..., half:]
    cos = jnp.cos(ang).astype(x.dtype)
    sin = jnp.sin(ang).astype(x.dtype)
    return jnp.concatenate([x1 * cos - x2 * sin, x1 * sin + x2 * cos], -1)


def axial_rope(x, ang_row, ang_col):
    if x.ndim == 4:
        ang_row, ang_col = ang_row[:, None], ang_col[:, None]
    half = x.shape[-1] // 2
    return jnp.concatenate([_rotate(x[..., :half], ang_row), _rotate(x[..., half:], ang_col)], -1)


def grid_angles(n):
    t = jnp.arange(n, dtype=jnp.int32)
    row = (t // GRID_W).astype(jnp.float32)
    col = (t % GRID_W).astype(jnp.float32)
    n_freq = MLA_ROPE // 4
    inv = 1.0 / (ROPE_THETA ** (jnp.arange(n_freq, dtype=jnp.float32) / n_freq))
    return row[:, None] * inv, col[:, None] * inv


def neighbourhood_attention(q, k, v, kc, vc, rel_bias):
    b, s, h, dh = q.shape
    rows = s // GRID_W
    kh = min(NA_KH, rows)
    n_loc = kh * NA_KW
    scale = dh ** -0.5
    cols = jnp.arange(GRID_W)
    col_start = jnp.clip(cols - NA_KW // 2, 0, GRID_W - NA_KW)
    key_cols = col_start[:, None] + jnp.arange(NA_KW)
    dcol = key_cols - cols[:, None] + NA_KW - 1

    def row_fn(r):
        row_start = jnp.clip(r - kh // 2, 0, rows - kh)
        key_rows = row_start + jnp.arange(kh)
        idx = (key_rows[None, :, None] * GRID_W + key_cols[:, None, :]).reshape(GRID_W, n_loc)
        drow = key_rows - r + NA_KH - 1
        bias = rel_bias[:, drow[None, :, None], dcol[:, None, :]].reshape(h, GRID_W, n_loc)
        q_r = lax.dynamic_slice_in_dim(q, r * GRID_W, GRID_W, axis=1)
        k_g = jnp.take(k, idx, axis=1)
        v_g = jnp.take(v, idx, axis=1)
        s_loc = jnp.einsum('bqhd,bqkhd->bhqk', q_r, k_g) * scale + bias
        s_ctx = jnp.einsum('bqhd,bkhd->bhqk', q_r, kc) * scale
        p = softmax_f32(jnp.concatenate([s_loc, s_ctx], -1), v)
        return (jnp.einsum('bhqk,bqkhd->bqhd', p[..., :n_loc], v_g)
                + jnp.einsum('bhqk,bkhd->bqhd', p[..., n_loc:], vc))

    out = lax.map(row_fn, jnp.arange(rows))
    return jnp.moveaxis(out, 0, 1).reshape(b, s, h, dh)


def dense_attention(q, k, v, scale):
    s = jnp.einsum('bqhd,bkhd->bhqk', q, k) * scale
    return jnp.einsum('bhqk,bkhd->bqhd', softmax_f32(s, v), v)


def mla_attention(qn, qr, kn, kr, v, scale):
    b, n, h, _ = qn.shape
    nb = n // Q_BLOCK

    def blk(args):
        qn_b, qr_b = args
        s = (jnp.einsum('bqhd,bkhd->bhqk', qn_b, kn) + jnp.einsum('bqhr,bkr->bhqk', qr_b, kr)) * scale
        return jnp.einsum('bhqk,bkhd->bqhd', softmax_f32(s, v), v)

    qn_blocks = qn.reshape(b, nb, Q_BLOCK, h, qn.shape[-1]).swapaxes(0, 1)
    qr_blocks = qr.reshape(b, nb, Q_BLOCK, h, qr.shape[-1]).swapaxes(0, 1)
    out = lax.map(blk, (qn_blocks, qr_blocks))
    return out.swapaxes(0, 1).reshape(b, n, h, v.shape[-1])


def _project(hh, w_in, q_norm, w_q_up, kv_norm, w_kv_up):
    bsz, n, _ = hh.shape
    qa, ka, va, q_c, kv_c, k_rope = jnp.split(hh @ w_in, SPLITS, axis=-1)
    heads = lambda t: t.reshape(bsz, n, NA_HEADS, NA_HEAD_DIM)
    q_mla = (rms_norm(q_c, q_norm) @ w_q_up).reshape(bsz, n, MLA_HEADS, MLA_NOPE + MLA_ROPE)
    kv_mla = (rms_norm(kv_c, kv_norm) @ w_kv_up).reshape(bsz, n, MLA_HEADS, MLA_NOPE + MLA_V)
    return (heads(qa), heads(ka), heads(va), q_mla[..., :MLA_NOPE], q_mla[..., MLA_NOPE:],
            kv_mla[..., :MLA_NOPE], k_rope, kv_mla[..., MLA_NOPE:])


def attention_mixer(h_lat, h_ctx, w_in, rel_bias, q_norm, w_q_up, kv_norm, w_kv_up, w_out, with_ctx_out):
    b, s, _ = h_lat.shape
    qa, ka, va, qn, qr, kn, kr, vb = _project(h_lat, w_in, q_norm, w_q_up, kv_norm, w_kv_up)
    qa_c, ka_c, va_c, qn_c, qr_c, kn_c, kr_c, vb_c = _project(h_ctx, w_in, q_norm, w_q_up, kv_norm, w_kv_up)
    ang_r, ang_c = grid_angles(s)
    qr = axial_rope(qr, ang_r, ang_c)
    kr = axial_rope(kr, ang_r, ang_c)
    mla_scale = (MLA_NOPE + MLA_ROPE) ** -0.5
    o_a = neighbourhood_attention(qa, ka, va, ka_c, va_c, rel_bias)
    o_b = mla_attention(qn, qr, jnp.concatenate([kn_c, kn], 1), jnp.concatenate([kr_c, kr], 1),
                        jnp.concatenate([vb_c, vb], 1), mla_scale)
    y_lat = jnp.concatenate([o_a.reshape(b, s, NA_W), o_b.reshape(b, s, MLA_OUT_W)], -1) @ w_out
    if not with_ctx_out:
        return y_lat, None
    n_ctx = h_ctx.shape[1]
    o_a_c = dense_attention(qa_c, ka_c, va_c, NA_HEAD_DIM ** -0.5)
    o_b_c = mla_attention(qn_c, qr_c, kn_c, kr_c, vb_c, mla_scale)
    y_ctx = jnp.concatenate([o_a_c.reshape(b, n_ctx, NA_W), o_b_c.reshape(b, n_ctx, MLA_OUT_W)], -1) @ w_out
    return y_lat, y_ctx


def pool_mixer(h, w, scale):
    b, n, d = h.shape
    t = jnp.arange(n)
    half = jnp.array(POOL_WINDOWS, dtype=jnp.int32) // 2
    lo = jnp.clip(t[:, None] - half, 0, n)
    hi = jnp.clip(t[:, None] + half, 0, n)
    cnt = (hi - lo).astype(jnp.float32)
    hf = h.astype(jnp.float32).reshape(b, n, POOL_GROUPS, POOL_GROUP)
    cs = jnp.concatenate([jnp.zeros((b, 1, POOL_GROUPS, POOL_GROUP), jnp.float32), jnp.cumsum(hf, axis=1)], 1)
    grp = jnp.arange(POOL_GROUPS)
    win_sum = cs[:, hi, grp] - cs[:, lo, grp]
    mixed = (win_sum / cnt[..., None] - hf).astype(h.dtype)
    return jnp.einsum('bngc,gcd->bngd', mixed, w).reshape(b, n, d) * scale


def swiglu(h, wg, wu, wd):
    return (jax.nn.silu(h @ wg) * (h @ wu)) @ wd


def moe_swiglu(h, router, wg, wu, wd):
    logits = (h @ router).astype(jnp.float32)
    top_val, top_idx = lax.top_k(logits, TOP_K)
    top_w = jax.nn.softmax(top_val, axis=-1)
    gates = jnp.sum(jax.nn.one_hot(top_idx, N_EXPERTS, dtype=jnp.float32) * top_w[..., None], axis=-2).astype(h.dtype)
    out = jnp.zeros_like(h)
    for e in range(N_EXPERTS):
        out = out + gates[..., e:e + 1] * swiglu(h, wg[e], wu[e], wd[e])
    return out


def setup_inputs(seed: int = 0) -> dict:
    key = jax.random.key(seed)
    ks = iter(jax.random.split(key, 40))

    def nrm(shape, scale):
        return jax.random.normal(next(ks), shape, jnp.float32) * scale

    D = D_MODEL
    beta = DEEPNORM_BETA
    return {
        'x': nrm((BATCH, SEQ, D), 1.0),
        'c': nrm((BATCH, D), 1.0),
        'ctx': nrm((BATCH, CTX_LEN, D), 1.0),
        'c_ctx': nrm((D,), 1.0),
        'mod_w': nrm((DEPTH, D, 6 * D), D ** -0.5),
        'mod_b': nrm((DEPTH, 6 * D), 0.02),
        'ln1_g': 1.0 + nrm((DEPTH, D), 0.02),
        'ln1_b': nrm((DEPTH, D), 0.02),
        'ln2_g': 1.0 + nrm((DEPTH, D), 0.02),
        'ln2_b': nrm((DEPTH, D), 0.02),
        'attn_w_in': nrm((N_ATTN_LAYERS, D, IN_COLS), D ** -0.5),
        'na_rel_bias': nrm((N_ATTN_LAYERS, NA_HEADS, 2 * NA_KH - 1, 2 * NA_KW - 1), 0.5),
        'mla_q_norm': 1.0 + nrm((N_ATTN_LAYERS, MLA_Q_LORA), 0.02),
        'mla_w_q_up': nrm((N_ATTN_LAYERS, MLA_Q_LORA, MLA_HEADS * (MLA_NOPE + MLA_ROPE)), MLA_Q_LORA ** -0.5),
        'mla_kv_norm': 1.0 + nrm((N_ATTN_LAYERS, MLA_KV_LORA), 0.02),
        'mla_w_kv_up': nrm((N_ATTN_LAYERS, MLA_KV_LORA, MLA_HEADS * (MLA_NOPE + MLA_V)), MLA_KV_LORA ** -0.5),
        'attn_w_out': nrm((N_ATTN_LAYERS, MIX_W, D), MIX_W ** -0.5 * beta),
        'ffn_w_gate': nrm((N_ATTN_LAYERS, D, FFN_DIM), D ** -0.5),
        'ffn_w_up': nrm((N_ATTN_LAYERS, D, FFN_DIM), D ** -0.5),
        'ffn_w_down': nrm((N_ATTN_LAYERS, FFN_DIM, D), FFN_DIM ** -0.5 * beta),
        'pool_w': nrm((N_POOL_LAYERS, POOL_GROUPS, POOL_GROUP, POOL_GROUP), POOL_GROUP ** -0.5 * beta),
        'pool_scale': 1.0 + nrm((N_POOL_LAYERS, D), 0.02),
        'moe_router': nrm((N_POOL_LAYERS, D, N_EXPERTS), D ** -0.5),
        'moe_w_gate': nrm((N_POOL_LAYERS, N_EXPERTS, D, EXPERT_DIM), D ** -0.5),
        'moe_w_up': nrm((N_POOL_LAYERS, N_EXPERTS, D, EXPERT_DIM), D ** -0.5),
        'moe_w_down': nrm((N_POOL_LAYERS, N_EXPERTS, EXPERT_DIM, D), EXPERT_DIM ** -0.5 * beta),
    }


def reference(x, c, ctx, c_ctx, mod_w, mod_b, ln1_g, ln1_b, ln2_g, ln2_b, attn_w_in, na_rel_bias,
              mla_q_norm, mla_w_q_up, mla_kv_norm, mla_w_kv_up, attn_w_out, ffn_w_gate, ffn_w_up,
              ffn_w_down, pool_w, pool_scale, moe_router, moe_w_gate, moe_w_up, moe_w_down):
    for i in range(DEPTH):
        j = i // 2
        even = i % 2 == 0
        ctx_live = any(l % 2 == 0 for l in range(i + 1, DEPTH))
        m_lat = (jax.nn.silu(c) @ mod_w[i] + mod_b[i])[:, None, :]
        sh1, sc1, g1, sh2, sc2, g2 = jnp.split(m_lat, 6, axis=-1)
        m_ctx = jax.nn.silu(c_ctx) @ mod_w[i] + mod_b[i]
        csh1, csc1, cg1, csh2, csc2, cg2 = jnp.split(m_ctx, 6, axis=-1)

        h_lat = modulate(x, sh1, sc1)
        if even:
            h_ctx = modulate(ctx, csh1, csc1)
            y_lat, y_ctx = attention_mixer(h_lat, h_ctx, attn_w_in[j], na_rel_bias[j], mla_q_norm[j],
                                           mla_w_q_up[j], mla_kv_norm[j], mla_w_kv_up[j], attn_w_out[j],
                                           ctx_live)
        else:
            y_lat = pool_mixer(h_lat, pool_w[j], pool_scale[j])
            y_ctx = pool_mixer(modulate(ctx, csh1, csc1), pool_w[j], pool_scale[j]) if ctx_live else None
        x = layer_norm(DEEPNORM_ALPHA * x + g1 * y_lat, ln1_g[i], ln1_b[i])
        if ctx_live:
            ctx = layer_norm(DEEPNORM_ALPHA * ctx + cg1 * y_ctx, ln1_g[i], ln1_b[i])

        h = modulate(x, sh2, sc2)
        n_ctx = ctx.shape[1] if ctx_live else 0
        if ctx_live:
            h = jnp.concatenate([modulate(ctx, csh2, csc2), h], axis=1)
        if even:
            y = swiglu(h, ffn_w_gate[j], ffn_w_up[j], ffn_w_down[j])
        else:
            y = moe_swiglu(h, moe_router[j], moe_w_gate[j], moe_w_up[j], moe_w_down[j])
        x = layer_norm(DEEPNORM_ALPHA * x + g2 * y[:, n_ctx:], ln2_g[i], ln2_b[i])
        if ctx_live:
            ctx = layer_norm(DEEPNORM_ALPHA * ctx + cg2 * y[:, :n_ctx], ln2_g[i], ln2_b[i])
    return x
```

```cpp
#include <hip/hip_runtime.h>
#include <cstdio>
#include <cstdint>

#ifndef ONE_LAUNCH
#define ONE_LAUNCH 1
#endif
#ifndef PROBE_PHASE
#define PROBE_PHASE -1
#endif
#ifndef PROBE_HI
#define PROBE_HI (PROBE_PHASE + 1)
#endif
#ifndef PHASE_EN
#define PHASE_EN 0x1ffffu
#endif
#define EN(k) (((PHASE_EN) >> (k)) & 1u)

#define GAS __attribute__((address_space(1)))
#define LAS __attribute__((address_space(3)))
typedef unsigned short bf16;
typedef short bf16x8 __attribute__((ext_vector_type(8)));
typedef short s16x4 __attribute__((ext_vector_type(4)));
typedef float f32x2 __attribute__((ext_vector_type(2)));
typedef float f32x4 __attribute__((ext_vector_type(4)));
typedef float f32x16 __attribute__((ext_vector_type(16)));
typedef unsigned u32x2 __attribute__((ext_vector_type(2)));
typedef unsigned u32x4 __attribute__((ext_vector_type(4)));
typedef __bf16 bf16x2_t __attribute__((ext_vector_type(2)));

constexpr int D = 1024, NLAT = 16384, NCTX = 256, NTOK = NLAT + NCTX;
constexpr int GRID_W = 64;
constexpr int PROJ_LD = 2048, IN_COLS = 1952;
constexpr int QM_LD = 768, KM_LD = 768, VM_LD = 512;
constexpr int FFN = 2816, EDIM = 3584, NEXP = 8;
constexpr int UP_N = 1792, UP_K = 384;
constexpr float ALPHA = 1.681792830507429f;
constexpr float LOG2E = 1.4426950408889634f;
constexpr float QS_NA = 0.125f * LOG2E;
constexpr float QS_MLA = 0.10206207261596575f * LOG2E;
constexpr float LN_EPS = 1e-5f, RMS_EPS = 1e-6f;
constexpr int MAXPANELS = 138;
constexpr float W8_SCALE = 32.f, W8_INV = 1.f / 32.f;

constexpr size_t MiB = 1u << 20;
constexpr size_t WS_CTL = 0, CTL_ZERO_BYTES = 1 * MiB;
constexpr size_t WS_MODV = 1 * MiB;
constexpr size_t WS_ROPE = 1 * MiB + 256 * 1024;
constexpr size_t WS_WSCM = 1 * MiB + 512 * 1024;
constexpr size_t WS_XC = 2 * MiB;
constexpr size_t WS_SSQ = 3 * MiB;
constexpr size_t WS_HSCM = 4 * MiB + 512 * 1024;
constexpr size_t WS_KMAXP = 4 * MiB + 768 * 1024;
constexpr size_t WS_ROWSLOT = 5 * MiB;
constexpr size_t WS_LISTTOK = 6 * MiB;
constexpr size_t WS_LISTW = 7 * MiB;
constexpr size_t WS_WSC = 7 * MiB + 768 * 1024;
constexpr size_t WS_WSCI = 7 * MiB + 832 * 1024;
constexpr size_t WS_HSC = 7 * MiB + 896 * 1024;
constexpr size_t WS_WIN = 8 * MiB;
constexpr size_t WS_WUP = 16 * MiB;
constexpr size_t WS_WPOOL = 19 * MiB;
constexpr size_t WS_WOUT = 20 * MiB;
constexpr size_t WS_WGU = 24 * MiB;
constexpr size_t WS_WDN = 46 * MiB;
constexpr size_t WS_MGU = 58 * MiB;
constexpr size_t WS_MDN = 282 * MiB;
constexpr size_t WS_H = 394 * MiB;
constexpr size_t WS_OB = 427 * MiB;
constexpr size_t WS_PROJ = 460 * MiB;
constexpr size_t WS_QM = 525 * MiB;
constexpr size_t WS_KM = 550 * MiB;
constexpr size_t WS_VM = 575 * MiB;
constexpr size_t WS_HID = 592 * MiB;
constexpr size_t WS_HIDM = 460 * MiB;
constexpr size_t WS_APERM = 702 * MiB;
constexpr size_t WS_OUT2 = 772 * MiB;
constexpr size_t WS_END = 842 * MiB;
static_assert(WS_HID + (size_t)NTOK * FFN * 2 <= WS_APERM && WS_HIDM + (size_t)MAXPANELS * 256 * EDIM * 2 <= WS_APERM && WS_APERM + (size_t)MAXPANELS * 256 * D * 2 <= WS_OUT2 && WS_OUT2 + (size_t)MAXPANELS * 256 * D * 2 <= WS_END, "ws map");
static_assert(WS_MGU + 16 * 14 * MiB <= WS_MDN && WS_MDN + 16 * 7 * MiB <= WS_H && WS_H + (size_t)NTOK * D * 2 <= WS_OB && WS_OB + (size_t)NTOK * D * 2 <= WS_PROJ, "ws map 2");
static_assert(WS_PROJ + (size_t)NTOK * PROJ_LD * 2 <= WS_QM && WS_QM + (size_t)NTOK * QM_LD * 2 <= WS_KM && WS_KM + (size_t)NTOK * KM_LD * 2 <= WS_VM && WS_VM + (size_t)NTOK * VM_LD * 2 <= WS_HID, "ws map 3");
constexpr int CW_BAR = 4096;
constexpr int CW_CNT = 8192;
constexpr int CW_KMAX = 12288;

__device__ __forceinline__ unsigned cvtpk(float lo, float hi) { f32x2 v = {lo, hi}; bf16x2_t b = __builtin_convertvector(v, bf16x2_t); return __builtin_bit_cast(unsigned, b); }
__device__ __forceinline__ float bf_lo(unsigned w) { return __uint_as_float(w << 16); }
__device__ __forceinline__ float bf_hi(unsigned w) { return __uint_as_float(w & 0xffff0000u); }
__device__ __forceinline__ float wave_sum(float v) {
#pragma unroll
    for (int o = 1; o < 64; o <<= 1) v += __shfl_xor(v, o);
    return v;
}
#define LDS_WAIT() asm volatile("s_waitcnt lgkmcnt(0)" ::: "memory")
#define VM_WAIT() asm volatile("s_waitcnt vmcnt(0)" ::: "memory")

namespace pg8 {
constexpr int BM = 256, BK = 64, HALF = 128, HTB = HALF * BK * 2, STAGE_BYTES = 8 * HTB, NXCD = 8, WGM = 8;
__device__ __forceinline__ int lds_byte(int r, int c) { const int st = (r >> 4) * 2 + (c >> 5), rr = r & 15, cc = c & 31, ob = rr * 64 + cc * 2; return st * 1024 + (ob ^ (((ob >> 9) & 1) << 5)); }
__device__ __forceinline__ void stage_rc(int b, int& R, int& C) { const int st = b / 1024, sb = b % 1024, swz = sb ^ (((sb >> 9) & 1) << 5); R = (st >> 1) * 16 + swz / 64; C = (st & 1) * 32 + (swz % 64) / 2; }
__device__ __forceinline__ int perm32(int rho) { const int n = rho >> 4, i = rho & 15; return 8 * (i >> 2) + 4 * n + (i & 3); }

typedef int v8i32 __attribute__((ext_vector_type(8)));
typedef int v4i32 __attribute__((ext_vector_type(4)));
__device__ __forceinline__ v4i32 ifrag_lo(v8i32 f) { return __builtin_shufflevector(f, f, 0, 1, 2, 3); }
__device__ __forceinline__ v4i32 ifrag_hi(v8i32 f) { return __builtin_shufflevector(f, f, 4, 5, 6, 7); }
template <bool I8> struct AccSel { typedef f32x4 T; };
template <> struct AccSel<true> { typedef v4i32 T; };
__device__ __forceinline__ bf16x8 frag_lo(v8i32 f) { const v4i32 a = __builtin_shufflevector(f, f, 0, 1, 2, 3); return __builtin_bit_cast(bf16x8, a); }
__device__ __forceinline__ bf16x8 frag_hi(v8i32 f) { const v4i32 a = __builtin_shufflevector(f, f, 4, 5, 6, 7); return __builtin_bit_cast(bf16x8, a); }
struct Unit { int pm, pn, aux, p0, ne; const char* a; const char* b; };

struct DenseOrder {
    int nM, nN, nwg, G, c, pm0; const char* A; const char* B; size_t astep, acs, bstep;
    __device__ __forceinline__ void init(int nM_, int nN_, int pm0_, int G_, int c_, const void* A_, size_t astep_, size_t acs_, const void* B_, size_t bstep_) {
        asm volatile("" : "+s"(c_));
        nM = nM_; nN = nN_; nwg = nM * nN; G = G_; c = c_; pm0 = pm0_; A = (const char*)A_; B = (const char*)B_; astep = astep_; acs = acs_; bstep = bstep_; }
    __device__ __forceinline__ bool next(int i, Unit& u) const {
        const long L = (long)i * G + c; if (L >= nwg) return false;
        int wgid = (int)L; { const int q = nwg / NXCD, r = nwg % NXCD, xcd = wgid % NXCD, off = wgid / NXCD; wgid = (xcd < r ? xcd * (q + 1) : r * (q + 1) + (xcd - r) * q) + off; }
        const int nig = WGM * nN, gid = wgid / nig, fm = gid * WGM, gsz = (nM - fm) < WGM ? (nM - fm) : WGM;
        u.pm = pm0 + fm + ((wgid % nig) % gsz); u.pn = (wgid % nig) / gsz; u.aux = 0; u.p0 = 0; u.ne = 0;
        u.a = A + (size_t)u.pm * astep + (size_t)u.pn * acs; u.b = B + (size_t)u.pn * bstep; return true;
    }
};
struct MoeOrder {
    int np[8], pb[8], ne[8]; int total, nN, G, c, ncol; const char* A; const char* B; size_t astep, bexp, bstep, ksb;
    __device__ __forceinline__ void init(const unsigned* cnt, int nN_, int G_, int c_, const void* A_, size_t astep_, const void* B_, size_t bexp_, size_t bstep_, int ncol_, size_t ksb_) {
        ncol = ncol_; ksb = ksb_;
        int p = 0;
#pragma unroll
        for (int e = 0; e < 8; ++e) { const int n = (int)__hip_atomic_load(cnt + 64 * e, __ATOMIC_RELAXED, __HIP_MEMORY_SCOPE_AGENT); ne[e] = n; np[e] = (n + 255) >> 8; pb[e] = p; p += np[e]; }
        asm volatile("" : "+s"(c_));
        nN = nN_; total = p * nN; G = G_; c = c_; A = (const char*)A_; B = (const char*)B_; astep = astep_; bexp = bexp_; bstep = bstep_;
    }
    __device__ __forceinline__ bool next(int i, Unit& u) const {
        const int L = i * G + c; if (L >= total) return false;
        int es = 0, cums = 0, nps = 1, pbs = 0, nes = 0, cum = 0;
#pragma unroll
        for (int e = 0; e < 8; ++e) { const int cn = np[e] * nN; const bool in = (L >= cum) && (L < cum + cn); if (in) { es = e; cums = cum; nps = np[e]; pbs = pb[e]; nes = ne[e]; } cum += cn; }
        const int local = L - cums; int pn, pl;
        if (ksb) { pl = local / nN; pn = local - pl * nN; }
        else { pn = local / nps; pl = local - pn * nps; }
        const int ks = pn / ncol, pc = pn - ks * ncol;
        u.pm = pbs + pl; u.pn = pc; u.aux = es | (ks << 8); u.p0 = pl * 256; u.ne = nes;
        u.a = A + (size_t)u.pm * astep + (size_t)ks * ksb; u.b = B + (size_t)es * bexp + (size_t)pc * bstep + (size_t)ks * ksb; return true;
    }
};

template <class Epi, class Sched, int MODE = 0>
__device__ __forceinline__ void gemm_phase(LAS unsigned char* lds, const int K, const int lda, const int ldb, const Sched& S, const Epi& E) {
    constexpr bool FP8 = (MODE == 1), I8 = (MODE == 2);
    typedef typename AccSel<I8>::T acc_t;
    int tid_ = threadIdx.x; asm volatile("" : "+v"(tid_));
    const int tid = tid_, wid = __builtin_amdgcn_readfirstlane(tid >> 6), lane = tid & 63, wr = wid >> 2, wc = wid & 3, fr = lane & 15, fq = lane >> 4;
    int nt = K / BK; asm volatile("" : "+s"(nt));
    unsigned voffA[2], voffB[2];
#pragma unroll
    for (int i = 0; i < 2; ++i) { int R, C; stage_rc(tid * 16 + i * 8192, R, C); const int Rb = Epi::PERM ? ((R & ~31) + perm32(R & 31)) : R;
        voffA[i] = (unsigned)(R * lda + C) * 2u; voffB[i] = (unsigned)(Rb * ldb + C) * 2u; }
    const size_t kstep = (size_t)(BK * 2);
    const size_t hstepA = (size_t)HALF * lda * 2, hstepB = (size_t)HALF * ldb * 2;
    const unsigned ldsw = (unsigned)wid * 1024u;
    const int aoff = lds_byte(wr * 64 + fr, fq * 8), boff = lds_byte(wc * 32 + fr, fq * 8);
#define PG8_SA(b, h) (((b) * 2 + (h)) * HTB)
#define PG8_SB(b, h) ((4 + (b) * 2 + (h)) * HTB)
#define PG8_STAGE(bufoff, gbase, voff) do { _Pragma("unroll") for (int _i = 0; _i < 2; ++_i) \
        __builtin_amdgcn_global_load_lds((const unsigned*)((const char*)(gbase) + (voff)[_i]), (LAS unsigned*)(lds + (bufoff) + ldsw + _i * 8192), 16, 0, 0); } while (0)
#define PG8_LDA(dst, b, h) do { _Pragma("unroll") for (int m = 0; m < 4; ++m) { const v4i32 lo_ = *(const LAS v4i32*)(lds + PG8_SA(b, h) + aoff + m * 2048), hi_ = *(const LAS v4i32*)(lds + PG8_SA(b, h) + aoff + m * 2048 + 1024); dst[m] = __builtin_shufflevector(lo_, hi_, 0, 1, 2, 3, 4, 5, 6, 7); } } while (0)
#define PG8_LDB(dst, b, h) do { _Pragma("unroll") for (int n = 0; n < 2; ++n) { const v4i32 lo_ = *(const LAS v4i32*)(lds + PG8_SB(b, h) + boff + n * 2048), hi_ = *(const LAS v4i32*)(lds + PG8_SB(b, h) + boff + n * 2048 + 1024); dst[n] = __builtin_shufflevector(lo_, hi_, 0, 1, 2, 3, 4, 5, 6, 7); } } while (0)
#define PG8_MMA(ai, bj, At, Bt) do { __builtin_amdgcn_s_setprio(1); _Pragma("unroll") for (int m = 0; m < 4; ++m) _Pragma("unroll") for (int n = 0; n < 2; ++n) { \
        if constexpr (FP8) { asm volatile("v_mfma_scale_f32_16x16x128_f8f6f4 %0, %1, %2, %0, %3, %3 op_sel_hi:[0,0,0]" : "+v"(acc[ai][bj][m][n]) : "v"(Bt[n]), "v"(At[m]), "v"(one8)); } \
        else if constexpr (I8) { acc[ai][bj][m][n] = __builtin_amdgcn_mfma_i32_16x16x64_i8(ifrag_lo(Bt[n]), ifrag_lo(At[m]), acc[ai][bj][m][n], 0, 0, 0); \
               acc[ai][bj][m][n] = __builtin_amdgcn_mfma_i32_16x16x64_i8(ifrag_hi(Bt[n]), ifrag_hi(At[m]), acc[ai][bj][m][n], 0, 0, 0); } \
        else { acc[ai][bj][m][n] = __builtin_amdgcn_mfma_f32_16x16x32_bf16(frag_lo(Bt[n]), frag_lo(At[m]), acc[ai][bj][m][n], 0, 0, 0); \
               acc[ai][bj][m][n] = __builtin_amdgcn_mfma_f32_16x16x32_bf16(frag_hi(Bt[n]), frag_hi(At[m]), acc[ai][bj][m][n], 0, 0, 0); } } \
        __builtin_amdgcn_s_setprio(0); } while (0)
#define PG8_WAIT_V(n) asm volatile("s_waitcnt vmcnt(" #n ")" ::: "memory")
#define PG8_WAIT_L(n) asm volatile("s_waitcnt lgkmcnt(" #n ")" ::: "memory")
#define PG8_BAR __builtin_amdgcn_s_barrier()
#define PG8_SCHED __builtin_amdgcn_sched_barrier(0)
    Unit cur, nxt; int ui = 0;
    if (!S.next(0, cur)) return;
    acc_t acc[2][2][4][2];
#pragma unroll
    for (int a = 0; a < 2; ++a)
#pragma unroll
        for (int b = 0; b < 2; ++b)
#pragma unroll
            for (int m = 0; m < 4; ++m)
#pragma unroll
                for (int n = 0; n < 2; ++n) acc[a][b][m][n] = acc_t{};
    int one8 = 0x7f7f7f7f; asm volatile("" : "+v"(one8));
    v8i32 At[4], B0[2], B1[2];
    const char* cA = cur.a; const char* cB = cur.b;
    typename Epi::Pre pre = E.pre(cur, wr, wc, fr, fq);
    PG8_STAGE(PG8_SB(0, 0), cB, voffB); PG8_STAGE(PG8_SB(0, 1), cB + hstepB, voffB); PG8_STAGE(PG8_SA(0, 0), cA, voffA); PG8_STAGE(PG8_SA(0, 1), cA + hstepA, voffA);
    if (wr == 1) PG8_BAR;
    PG8_WAIT_V(2); PG8_BAR;
    PG8_STAGE(PG8_SB(1, 0), cB + kstep, voffB); PG8_STAGE(PG8_SA(1, 0), cA + kstep, voffA); PG8_STAGE(PG8_SB(1, 1), cB + hstepB + kstep, voffB);
    PG8_WAIT_V(6); PG8_BAR;
    for (;;) {
        const bool has_next = S.next(ui + 1, nxt);
        const char* nA = has_next ? nxt.a : cA; const char* nB = has_next ? nxt.b : cB;
        for (int t = 0; t < nt; t += 2) {
            const bool last = (t == nt - 2);
            const char* a1 = cA + (size_t)(t + 1) * kstep;
            const char* a2 = last ? nA : cA + (size_t)(t + 2) * kstep; const char* b2 = last ? nB : cB + (size_t)(t + 2) * kstep;
            const char* a3 = a2 + kstep; const char* b3 = b2 + kstep;
            PG8_LDB(B0, 0, 0); PG8_LDB(B1, 0, 1); PG8_SCHED; PG8_LDA(At, 0, 0); PG8_STAGE(PG8_SA(1, 1), a1 + hstepA, voffA);
            PG8_WAIT_V(8); PG8_WAIT_L(0); PG8_BAR; PG8_MMA(0, 0, At, B0); PG8_MMA(0, 1, At, B1); PG8_BAR; PG8_SCHED;
            PG8_LDA(At, 0, 1); PG8_STAGE(PG8_SB(0, 0), b2, voffB); PG8_STAGE(PG8_SB(0, 1), b2 + hstepB, voffB); PG8_STAGE(PG8_SA(0, 0), a2, voffA);
            PG8_WAIT_V(8); PG8_WAIT_L(0); PG8_BAR; PG8_MMA(1, 0, At, B0); PG8_MMA(1, 1, At, B1); PG8_BAR; PG8_SCHED;
            PG8_LDB(B0, 1, 0); PG8_LDB(B1, 1, 1); PG8_SCHED; PG8_LDA(At, 1, 0); PG8_STAGE(PG8_SA(0, 1), a2 + hstepA, voffA);
            PG8_WAIT_V(8); PG8_WAIT_L(0); PG8_BAR; PG8_MMA(0, 0, At, B0); PG8_MMA(0, 1, At, B1); PG8_BAR; PG8_SCHED;
            PG8_LDA(At, 1, 1); PG8_STAGE(PG8_SB(1, 0), b3, voffB); PG8_STAGE(PG8_SB(1, 1), b3 + hstepB, voffB); PG8_STAGE(PG8_SA(1, 0), a3, voffA);
            PG8_WAIT_V(8); PG8_WAIT_L(0); PG8_BAR; PG8_MMA(1, 0, At, B0); PG8_MMA(1, 1, At, B1); PG8_BAR; PG8_SCHED;
        }
        if constexpr (FP8) asm volatile("s_nop 15\n\ts_nop 7" ::: "memory");
        if (wr == 0) PG8_BAR;
        { int te_ = threadIdx.x; asm volatile("" : "+v"(te_));
          const int le_ = te_ & 63; E(acc, cur, wr, wc, le_ & 15, le_ >> 4, pre); }
        if (!has_next) break;
#pragma unroll
        for (int a = 0; a < 2; ++a)
#pragma unroll
            for (int b = 0; b < 2; ++b)
#pragma unroll
                for (int m = 0; m < 4; ++m)
#pragma unroll
                    for (int n = 0; n < 2; ++n) acc[a][b][m][n] = acc_t{};
        cur = nxt; cA = nA; cB = nB; ++ui; pre = E.pre(cur, wr, wc, fr, fq);
        if (wr == 1) PG8_BAR;
    }
    PG8_WAIT_V(0);
    PG8_BAR;
#undef PG8_SA
#undef PG8_SB
#undef PG8_STAGE
#undef PG8_LDA
#undef PG8_LDB
#undef PG8_MMA
#undef PG8_WAIT_V
#undef PG8_WAIT_L
#undef PG8_BAR
#undef PG8_SCHED
}

__device__ __forceinline__ u32x4 pack8(const f32x4 v0, const f32x4 v1) { u32x4 w; w.x = cvtpk(v0[0], v0[1]); w.y = cvtpk(v0[2], v0[3]); w.z = cvtpk(v1[0], v1[1]); w.w = cvtpk(v1[2], v1[3]); return w; }

__device__ __forceinline__ void rope8(f32x4& v0, f32x4& v1, int t, int fq, const float* rope) {
    const int pos = (fq < 2) ? (t >> 6) : (t & (GRID_W - 1));
    const float* tb = rope + pos * 16;
    const f32x4 c0 = *(const f32x4*)(tb), c1 = *(const f32x4*)(tb + 4), s0 = *(const f32x4*)(tb + 8), s1 = *(const f32x4*)(tb + 12);
    f32x4 u0, u1;
#pragma unroll
    for (int i = 0; i < 4; ++i) { u0[i] = __shfl_xor(v0[i], 16); u1[i] = __shfl_xor(v1[i], 16); }
    if (fq & 1) { v0 = u0 * s0 + v0 * c0; v1 = u1 * s1 + v1 * c1; }
    else        { v0 = v0 * c0 - u0 * s0; v1 = v1 * c1 - u1 * s1; }
}

struct EpiProj {
    static constexpr bool PERM = true;
    bf16* PROJ; float* SSQ; bf16* KM; const float* rope; float* kmax; const float* hsc; const float* wsc;
    struct Pre { float sw[2]; float hs[8]; };
    __device__ __forceinline__ Pre pre(const Unit& u, int wr, int wc, int fr, int fq) const {
        Pre p; const int wrow = u.pn * BM + wc * 32 + 8 * fq, row0 = u.pm * BM + wr * 64 + fr;
        p.sw[0] = wsc[wrow]; p.sw[1] = wsc[wrow + HALF];
#pragma unroll
        for (int q = 0; q < 8; ++q) p.hs[q] = hsc[row0 + (q >> 2) * HALF + (q & 3) * 16];
        return p;
    }
    __device__ __forceinline__ void operator()(const v4i32 (&acc)[2][2][4][2], const Unit& u, int wr, int wc, int fr, int fq, const Pre& p) const {
        const int row0 = u.pm * BM + wr * 64 + fr, col0 = u.pn * BM + wc * 32 + 8 * fq; float kr2 = 0.f, ka2[2] = {0.f, 0.f};
#pragma unroll
        for (int ai = 0; ai < 2; ++ai)
#pragma unroll
            for (int m = 0; m < 4; ++m) { const int row = row0 + ai * HALF + m * 16;
#pragma unroll
                for (int bj = 0; bj < 2; ++bj) { const float sc_ = p.hs[ai * 4 + m] * p.sw[bj];
                    f32x4 v0 = __builtin_convertvector(acc[ai][bj][m][0], f32x4) * sc_, v1 = __builtin_convertvector(acc[ai][bj][m][1], f32x4) * sc_;
                    *(u32x4*)(PROJ + (size_t)row * PROJ_LD + col0 + bj * HALF) = pack8(v0, v1);
                    if (u.pn == 2 || u.pn == 3) { float s2 = (v0[0] * v0[0] + v0[1] * v0[1]) + (v0[2] * v0[2] + v0[3] * v0[3]) + (v1[0] * v1[0] + v1[1] * v1[1]) + (v1[2] * v1[2] + v1[3] * v1[3]);
                        s2 += __shfl_xor(s2, 16); s2 += __shfl_xor(s2, 32); ka2[bj] = fmaxf(ka2[bj], s2); }
                    if (u.pn == 6 || (u.pn == 7 && bj == 0)) {
                        float ss = (v0[0] * v0[0] + v0[1] * v0[1]) + (v0[2] * v0[2] + v0[3] * v0[3]) + (v1[0] * v1[0] + v1[1] * v1[1]) + (v1[2] * v1[2] + v1[3] * v1[3]);
                        ss += __shfl_xor(ss, 16); ss += __shfl_xor(ss, 32);
                        if (fq == 0) SSQ[(size_t)row * 16 + (u.pn == 6 ? bj * 4 + wc : 8 + wc)] = ss;
                    }
                    if (u.pn == 7 && bj == 1 && wc == 0) {
                        { float s2 = (v0[0] * v0[0] + v0[1] * v0[1]) + (v0[2] * v0[2] + v0[3] * v0[3]) + (v1[0] * v1[0] + v1[1] * v1[1]) + (v1[2] * v1[2] + v1[3] * v1[3]);
                          s2 += __shfl_xor(s2, 16); s2 += __shfl_xor(s2, 32); kr2 = fmaxf(kr2, s2); }
                        if (u.pm >= 1) rope8(v0, v1, row - NCTX, fq, rope);
                        const u32x4 w = pack8(v0, v1);
#pragma unroll
                        for (int h = 0; h < 8; ++h) *(u32x4*)(KM + (size_t)row * KM_LD + h * 96 + 64 + 8 * fq) = w;
                    }
                } }
        if (u.pn == 2 || u.pn == 3) {
#pragma unroll
            for (int bj = 0; bj < 2; ++bj) { float m = ka2[bj];
#pragma unroll
                for (int o = 1; o < 16; o <<= 1) m = fmaxf(m, __shfl_xor(m, o));
                if ((fr | fq) == 0) kmax[(17 + ((u.pn - 2) * 4 + bj * 2 + (wc >> 1)) * 2 + (wc & 1)) * 130 + u.pm * 2 + wr] = m; }
        }
        if (u.pn == 7 && wc == 0) {
#pragma unroll
            for (int o = 1; o < 16; o <<= 1) kr2 = fmaxf(kr2, __shfl_xor(kr2, o));
            if ((fr | fq) == 0) kmax[u.pm * 2 + wr] = kr2;
        }
    }
};
struct EpiUp {
    static constexpr bool PERM = true;
    struct Pre {}; __device__ __forceinline__ Pre pre(const Unit&, int, int, int, int) const { return Pre{}; }
    const float* SSQ; bf16* QM; bf16* KM; bf16* VM; const float* rope; float* kmax;
    __device__ __forceinline__ void operator()(const f32x4 (&acc)[2][2][4][2], const Unit& u, int wr, int wc, int fr, int fq, const Pre&) const {
        const int row0 = u.pm * BM + wr * 64 + fr; const bool isq = u.pn < 3; float kn2[2] = {0.f, 0.f};
#pragma unroll
        for (int ai = 0; ai < 2; ++ai)
#pragma unroll
            for (int m = 0; m < 4; ++m) { const int row = row0 + ai * HALF + m * 16; float r;
                if (isq) { const f32x4 a = *(const f32x4*)(SSQ + (size_t)row * 16), b = *(const f32x4*)(SSQ + (size_t)row * 16 + 4);
                    r = rsqrtf(((a[0] + a[1]) + (a[2] + a[3]) + (b[0] + b[1]) + (b[2] + b[3])) * (1.f / 256.f) + RMS_EPS); }
                else { const f32x4 a = *(const f32x4*)(SSQ + (size_t)row * 16 + 8); r = rsqrtf(((a[0] + a[1]) + (a[2] + a[3])) * (1.f / 128.f) + RMS_EPS); }
#pragma unroll
                for (int bj = 0; bj < 2; ++bj) { const int grp = u.pn * BM + bj * HALF + wc * 32, c0 = grp + 8 * fq;
                    f32x4 v0 = acc[ai][bj][m][0] * r, v1 = acc[ai][bj][m][1] * r;
                    if (isq) { if ((grp % 96) == 64 && u.pm >= 1) rope8(v0, v1, row - NCTX, fq, rope);
                        *(u32x4*)(QM + (size_t)row * QM_LD + c0) = pack8(v0, v1); }
                    else { const int cc = c0 - 768, head = cc >> 7, within = cc & 127;
                        if (within < 64) { *(u32x4*)(KM + (size_t)row * KM_LD + head * 96 + within) = pack8(v0, v1);
                            float s2 = (v0[0] * v0[0] + v0[1] * v0[1]) + (v0[2] * v0[2] + v0[3] * v0[3]) + (v1[0] * v1[0] + v1[1] * v1[1]) + (v1[2] * v1[2] + v1[3] * v1[3]);
                            s2 += __shfl_xor(s2, 16); s2 += __shfl_xor(s2, 32); kn2[bj] = fmaxf(kn2[bj], s2); }
                        else *(u32x4*)(VM + (size_t)row * VM_LD + head * 64 + within - 64) = pack8(v0, v1); }
                } }
        if (!isq && wc < 2) {
#pragma unroll
            for (int bj = 0; bj < 2; ++bj) { float m = kn2[bj];
#pragma unroll
                for (int o = 1; o < 16; o <<= 1) m = fmaxf(m, __shfl_xor(m, o));
                if ((fr | fq) == 0) kmax[(1 + ((u.pn - 3) * 2 + bj) * 2 + wc) * 130 + u.pm * 2 + wr] = m; }
        }
    }
};
struct EpiResid {
    static constexpr bool PERM = false;
    struct Pre {}; __device__ __forceinline__ Pre pre(const Unit&, int, int, int, int) const { return Pre{}; }
    float* Xl; float* Xc; const float* gate_lat; const float* gate_ctx; const float* Xsrc;
    float sc = 1.f;
    __device__ __forceinline__ void operator()(const f32x4 (&acc)[2][2][4][2], const Unit& u, int wr, int wc, int fr, int fq, const Pre&) const {
        const bool isctx = (u.pm == 0);
        float* Xb = isctx ? Xc : Xl + (size_t)(u.pm - 1) * BM * D; const float* gv = isctx ? gate_ctx : gate_lat;
        const float* Xs = isctx ? Xc : Xsrc + (size_t)(u.pm - 1) * BM * D;
        const int col0 = u.pn * BM + wc * 32 + 4 * fq;
        f32x4 g[2][2];
#pragma unroll
        for (int bj = 0; bj < 2; ++bj)
#pragma unroll
            for (int n = 0; n < 2; ++n) g[bj][n] = *(const f32x4*)(gv + col0 + bj * HALF + n * 16) * sc;
#pragma unroll
        for (int ai = 0; ai < 2; ++ai)
#pragma unroll
            for (int m = 0; m < 4; ++m) { float* xr = Xb + (size_t)(ai * HALF + wr * 64 + m * 16 + fr) * D + col0; const float* xs = Xs + (size_t)(ai * HALF + wr * 64 + m * 16 + fr) * D + col0;
#pragma unroll
                for (int bj = 0; bj < 2; ++bj)
#pragma unroll
                    for (int n = 0; n < 2; ++n) { f32x4 x = *(const f32x4*)(xs + bj * HALF + n * 16); x = x * ALPHA + g[bj][n] * acc[ai][bj][m][n]; *(f32x4*)(xr + bj * HALF + n * 16) = x; }
                if (m & 1) asm volatile("" ::: "memory"); }
    }
};
__device__ __forceinline__ float swi(float g, float up) { return g * up * __builtin_amdgcn_rcpf(1.f + __builtin_amdgcn_exp2f(-g * LOG2E)); }
struct EpiSwigluI8 {
    static constexpr bool PERM = true;
    bf16* HID; int ldh; const float* hsc; const float* wsc0; int wstride; bool out8;
    struct Pre { float sg, su; float hs[8]; };
    __device__ __forceinline__ Pre pre(const Unit& u, int wr, int wc, int fr, int fq) const {
        Pre p; const float* wsc = wsc0 + (size_t)(u.aux & 255) * wstride; const int wrow = u.pn * BM + wc * 32 + 8 * fq, row0 = u.pm * BM + wr * 64 + fr;
        p.sg = wsc[wrow]; p.su = wsc[wrow + HALF];
#pragma unroll
        for (int q = 0; q < 8; ++q) p.hs[q] = hsc[row0 + (q >> 2) * HALF + (q & 3) * 16];
        return p;
    }
    __device__ __forceinline__ void operator()(const v4i32 (&acc)[2][2][4][2], const Unit& u, int wr, int wc, int fr, int fq, const Pre& p) const {
        const int row0 = u.pm * BM + wr * 64 + fr, col0 = u.pn * HALF + wc * 32 + 8 * fq;
#pragma unroll
        for (int ai = 0; ai < 2; ++ai)
#pragma unroll
            for (int m = 0; m < 4; ++m) { const int row = row0 + ai * HALF + m * 16; const float cg = p.hs[ai * 4 + m] * p.sg, cu = p.hs[ai * 4 + m] * p.su; f32x4 h0, h1;
                const f32x2 cgm = {-LOG2E * cg, -LOG2E * cg}, cgu = {cg * cu, cg * cu};
#pragma unroll
                for (int n = 0; n < 2; ++n)
#pragma unroll
                    for (int i = 0; i < 4; i += 2) { const f32x2 g2 = {(float)acc[ai][0][m][n][i], (float)acc[ai][0][m][n][i + 1]}, u2 = {(float)acc[ai][1][m][n][i], (float)acc[ai][1][m][n][i + 1]};
                        const f32x2 t = g2 * cgm; f32x2 d; d.x = __builtin_amdgcn_exp2f(t.x); d.y = __builtin_amdgcn_exp2f(t.y); d = d + 1.0f;
                        f32x2 r; r.x = __builtin_amdgcn_rcpf(d.x); r.y = __builtin_amdgcn_rcpf(d.y);
                        const f32x2 o2 = (g2 * u2) * (r * cgu);
                        if (n == 0) { h0[i] = o2.x; h0[i + 1] = o2.y; } else { h1[i] = o2.x; h1[i + 1] = o2.y; } }
                if (out8) { int a = 0, b = 0; a = __builtin_amdgcn_cvt_pk_fp8_f32(h0[0], h0[1], a, false); a = __builtin_amdgcn_cvt_pk_fp8_f32(h0[2], h0[3], a, true);
                    b = __builtin_amdgcn_cvt_pk_fp8_f32(h1[0], h1[1], b, false); b = __builtin_amdgcn_cvt_pk_fp8_f32(h1[2], h1[3], b, true);
                    *(u32x2*)((unsigned char*)HID + (size_t)row * ldh + col0) = (u32x2){(unsigned)a, (unsigned)b}; }
                else *(u32x4*)(HID + (size_t)row * ldh + col0) = pack8(h0, h1); }
    }
};
struct EpiMoeDown {
    static constexpr bool PERM = true;
    struct Pre {}; __device__ __forceinline__ Pre pre(const Unit&, int, int, int, int) const { return Pre{}; }
    bf16* OUT0; bf16* OUT1; const float* listW; float sc;
    __device__ __forceinline__ void operator()(const f32x4 (&acc)[2][2][4][2], const Unit& u, int wr, int wc, int fr, int fq, const Pre&) const {
        const int col0 = u.pn * BM + wc * 32 + 8 * fq; const int e = u.aux & 255; bf16* OUT = (u.aux >> 8) ? OUT1 : OUT0;
#pragma unroll
        for (int ai = 0; ai < 2; ++ai)
#pragma unroll
            for (int m = 0; m < 4; ++m) { const int r = ai * HALF + wr * 64 + m * 16 + fr, p = u.p0 + r;
                const float w = (p < u.ne) ? listW[(size_t)e * NTOK + p] * sc : 0.f;
#pragma unroll
                for (int bj = 0; bj < 2; ++bj) *(u32x4*)(OUT + (size_t)(u.pm * BM + r) * D + col0 + bj * HALF) = pack8(acc[ai][bj][m][0] * w, acc[ai][bj][m][1] * w); }
    }
};
}


namespace mla {
using f32x16_t = f32x16;
constexpr int NW = 8, QBLK = 32, KVBLK = 64;
constexpr int NSLOT = 4, VSLOT = 8192;
template <int DQK> struct Lay {
    static constexpr int KSLOT = 64 * DQK * 2, LDS_K = 0, LDS_V = NSLOT * KSLOT, LDS_WS = LDS_V + NSLOT * VSLOT, LDS_OST = LDS_WS + NW * 64 * 4, LDS_BIAS = LDS_OST + NW * 4096, LDS_BYTES = LDS_BIAS + 2048 + 64;
};
#define SBAR() __builtin_amdgcn_sched_barrier(0)
__device__ __forceinline__ int crow(int r, int hi) { return (r & 3) + 8 * (r >> 2) + 4 * hi; }
__device__ __forceinline__ void glds16(const void* gbase  , unsigned voff  , unsigned lds_dst) { unsigned keep;
    asm volatile("s_mov_b32 %0, m0\n\ts_mov_b32 m0, %2\n\ts_nop 0\n\tglobal_load_lds_dwordx4 %1, %3\n\ts_mov_b32 m0, %0" : "=&s"(keep) : "v"(voff), "s"(lds_dst), "s"(gbase) : "memory"); }
__device__ __forceinline__ float max3f(float a, float b, float c) { float r; asm("v_max3_f32 %0, %1, %2, %3" : "=v"(r) : "v"(a), "v"(b), "v"(c)); return r; }
__device__ __forceinline__ float max2f(float a, float b) { float r; asm("v_max_f32_e32 %0, %1, %2" : "=v"(r) : "v"(a), "v"(b)); return r; }
__device__ __forceinline__ float fadd_s(float a, float b) { float r; asm("v_add_f32_e32 %0, %1, %2" : "=v"(r) : "v"(a), "v"(b)); return r; }
__device__ __forceinline__ float fsub_s(float a, float b) { float r; asm("v_sub_f32_e32 %0, %1, %2" : "=v"(r) : "v"(a), "v"(b)); return r; }
#define WAIT_BAR2(NL, NO) do { if (lead) asm volatile("s_waitcnt vmcnt(" #NL ") lgkmcnt(0)\n\ts_barrier" ::: "memory"); else asm volatile("s_waitcnt vmcnt(" #NO ") lgkmcnt(0)\n\ts_barrier" ::: "memory"); } while (0)
typedef LAS const char* lds_cptr;
typedef short v4i16_t __attribute__((ext_vector_type(4)));
__device__ __forceinline__ void kload2(bf16x8* kf, lds_cptr kp, int j) { kf[2 * j] = *(const LAS bf16x8*)(kp + j * 2048); kf[2 * j + 1] = *(const LAS bf16x8*)(kp + j * 2048 + 512); }
__device__ __forceinline__ s16x4 vtr(lds_cptr p) { return __builtin_bit_cast(s16x4, __builtin_amdgcn_ds_read_tr16_b64_v4i16((LAS v4i16_t*)p)); }
__device__ __forceinline__ float rowmax(const f32x16& p0, const f32x16& p1) {
    float a = max3f(p0[0], p0[1], p1[0]), b = max3f(p0[2], p0[3], p1[1]); a = max3f(a, p1[2], p1[3]);
#pragma unroll
    for (int r = 4; r < 16; r += 4) { a = max3f(a, p0[r], p0[r + 1]); b = max3f(b, p0[r + 2], p0[r + 3]); a = max3f(a, p1[r], p1[r + 1]); b = max3f(b, p1[r + 2], p1[r + 3]); }
    const float m = max2f(a, b);
    auto rr = __builtin_amdgcn_permlane32_swap(__float_as_uint(m), __float_as_uint(m), false, false);
    return max2f(__uint_as_float(rr[0]), __uint_as_float(rr[1]));
}
__device__ __forceinline__ void pv(f32x16* o, unsigned vb, bf16x8 pa0, bf16x8 pa1, bf16x8 pa2, bf16x8 pa3) {
#pragma unroll
    for (int d0 = 0; d0 < 2; ++d0) { s16x4 lo[4], hi[4];
#pragma unroll
        for (int ks = 0; ks < 4; ++ks) {
            asm volatile("ds_read_b64_tr_b16 %0,%1 offset:%c2" : "=&v"(lo[ks]) : "v"(vb), "i"(d0 * 4096 + ks * 1024) : "memory");
            asm volatile("ds_read_b64_tr_b16 %0,%1 offset:%c2" : "=&v"(hi[ks]) : "v"(vb), "i"(d0 * 4096 + ks * 1024 + 512) : "memory"); }
        asm volatile("s_waitcnt lgkmcnt(0)" ::: "memory"); SBAR();
#define PK(k) (bf16x8){lo[k][0], lo[k][1], lo[k][2], lo[k][3], hi[k][0], hi[k][1], hi[k][2], hi[k][3]}
        o[d0] = __builtin_amdgcn_mfma_f32_32x32x16_bf16(pa0, PK(0), o[d0], 0, 0, 0);
        o[d0] = __builtin_amdgcn_mfma_f32_32x32x16_bf16(pa1, PK(1), o[d0], 0, 0, 0);
        o[d0] = __builtin_amdgcn_mfma_f32_32x32x16_bf16(pa2, PK(2), o[d0], 0, 0, 0);
        o[d0] = __builtin_amdgcn_mfma_f32_32x32x16_bf16(pa3, PK(3), o[d0], 0, 0, 0);
#undef PK
    }
}
template <int DQK, bool NA, int LDQ, int LDK, int LDV, int LDO>
__device__ __forceinline__ void attn_unit(const bf16* Qw0, const bf16* __restrict__ Kh, const bf16* __restrict__ Vh, bf16* Ow0, const int NT, const float k2max  ,
                                          const int krs, const int qgrow, const float* __restrict__ biasg, LAS char* shm) {
    typedef Lay<DQK> L; constexpr int NF = DQK / 16, KSLOT = L::KSLOT, LDS_K = L::LDS_K, LDS_V = L::LDS_V, LDS_WS = L::LDS_WS, LDS_OST = L::LDS_OST;
    int tid_ = threadIdx.x; asm volatile("" : "+v"(tid_));
    const int tid = tid_, lane = tid & 63, r32 = lane & 31, hi = lane >> 5; const int wid = __builtin_amdgcn_readfirstlane(tid >> 6);
    const bool lead = (DQK == 96) && (wid < 4);
    LAS float* biasL = (LAS float*)(shm + L::LDS_BIAS); LAS float* bmaxL = (LAS float*)(shm + L::LDS_BIAS + 2048);
    const int qr_g = qgrow + (wid >> 1), qc = 32 * (wid & 1) + r32, rs = min(max(qr_g - 4, 0), 248), cs = min(max(qc - 8, 0), 48);
    if (NA) { float bv = -INFINITY; if (tid < 465) { bv = biasg[tid] * LOG2E; biasL[tid] = bv; }
#pragma unroll
        for (int o = 1; o < 64; o <<= 1) bv = fmaxf(bv, __shfl_xor(bv, o));
        if (lane == 0) bmaxL[wid] = bv; }
    const bf16* Qw = Qw0 + (size_t)(wid * QBLK) * LDQ;
    const unsigned lds0 = (unsigned)(uintptr_t)shm;
    LAS float* wsf = (LAS float*)(shm + LDS_WS) + wid * 64;
    const unsigned koff = (unsigned)(lane * LDK + wid * 8) * 2u;
    const unsigned voff = (unsigned)((16 * (wid & 3) + (lane >> 2)) * LDV + (wid >> 2) * 32 + (lane & 3) * 8) * 2u;
    const unsigned kdst = lds0 + LDS_K + wid * 1024, vdst = lds0 + LDS_V + wid * 1024;
#define TROW(t) ((NA && (t) >= 4) ? (NCTX + 64 * (krs + (t) - 4)) : 64 * (t))
#define DMA_K(t, slot) do { const bf16* kb_ = Kh + (size_t)TROW(t) * LDK; glds16(kb_, koff, (unsigned)__builtin_amdgcn_readfirstlane(kdst + (slot))); \
        if (lead) glds16(kb_ + 64, koff, (unsigned)__builtin_amdgcn_readfirstlane(kdst + 8192 + (slot))); } while (0)
#define DMA_V(t, vslot) glds16(Vh + (size_t)TROW(t) * LDV, voff, (unsigned)__builtin_amdgcn_readfirstlane(vdst + (vslot)))
    const unsigned vb0 = lds0 + LDS_V + ((lane >> 4) & 1) * 32 + (lane & 3) * 8 + (4 * hi + ((lane & 15) >> 2)) * 64;
    const LAS char* Kbase = shm + LDS_K; bf16x8 kf[2 * NF];
    const lds_cptr shm3 = (lds_cptr)shm; const lds_cptr kp0 = shm3 + LDS_K + hi * 1024 + r32 * 16;
    const lds_cptr vp0 = shm3 + LDS_V + ((lane >> 4) & 1) * 32 + (lane & 3) * 8 + (4 * hi + ((lane & 15) >> 2)) * 64;
#define KS(t) ((unsigned)((t) & 3) * (unsigned)KSLOT)
#define VS(t) ((unsigned)((t) & 3) * (unsigned)VSLOT)
    DMA_K(0, KS(0)); DMA_V(0, VS(0)); DMA_K(1, KS(1));
    bf16x8 qr[NF];
#pragma unroll
    for (int d0 = 0; d0 < NF; ++d0) qr[d0] = *(const bf16x8*)(&Qw[(size_t)r32 * LDQ + d0 * 16 + hi * 8]);
    float l_reg = 0.f; f32x16 o[2]; o[0] = f32x16{}; o[1] = f32x16{}; f32x16 negm;
    float q2 = 0.f;
#pragma unroll
    for (int d0 = 0; d0 < NF; ++d0) { const u32x4 w = __builtin_bit_cast(u32x4, qr[d0]);
#pragma unroll
      for (int i = 0; i < 4; ++i) { const float a = bf_lo(w[i]), c = bf_hi(w[i]); q2 += a * a + c * c; } }
    { auto rr = __builtin_amdgcn_permlane32_swap(__float_as_uint(q2), __float_as_uint(q2), false, false); q2 = __uint_as_float(rr[0]) + __uint_as_float(rr[1]); }
#define START(P0, P1) do { _Pragma("unroll") for (int r = 0; r < 16; ++r) P0[r] = __builtin_amdgcn_exp2f(P0[r]); } while (0)
#define RESC() do { } while (0)
    f32x16 pA0, pA1, pB0, pB1;
#define ROT() do { } while (0)
#define ENDW(tt) do { if ((tt) + 4 < NT) { WAIT_BAR2(6, 4); } else if ((tt) + 3 < NT) { WAIT_BAR2(4, 3); } else if ((tt) + 2 < NT) { WAIT_BAR2(2, 2); } else { WAIT_BAR2(0, 0); } } while (0)
    DMA_K(2, KS(2)); DMA_K(3, KS(3)); DMA_V(1, VS(1));
    WAIT_BAR2(5, 3);
    { float mref = sqrtf(q2 * k2max) * 1.01f + 0.01f;
      if (NA) { float bm = bmaxL[0];
#pragma unroll
        for (int w = 1; w < 8; ++w) bm = fmaxf(bm, bmaxL[w]);
        mref += fmaxf(bm, 0.f); }
      mref = fminf(mref, 100.f);
#pragma unroll
      for (int r = 0; r < 16; ++r) negm[r] = -mref;
      asm volatile("" : "+v"(negm)); }
    { const LAS char* kb = Kbase + hi * 1024 + r32 * 16;
#pragma unroll
      for (int d0 = 0; d0 < NF; ++d0) { const bf16x8 b0 = *(const LAS bf16x8*)(kb + d0 * 2048); const bf16x8 b1 = *(const LAS bf16x8*)(kb + d0 * 2048 + 512);
        if (d0 == 0) { pA0 = __builtin_amdgcn_mfma_f32_32x32x16_bf16(b0, qr[0], negm, 0, 0, 0); pA1 = __builtin_amdgcn_mfma_f32_32x32x16_bf16(b1, qr[0], negm, 0, 0, 0); }
        else { pA0 = __builtin_amdgcn_mfma_f32_32x32x16_bf16(b0, qr[d0], pA0, 0, 0, 0); pA1 = __builtin_amdgcn_mfma_f32_32x32x16_bf16(b1, qr[d0], pA1, 0, 0, 0); } } }
    asm volatile("s_nop 15\n\ts_nop 7" : "+v"(pA0), "+v"(pA1));
    START(pA0, pA1);
#pragma unroll
    for (int r = 0; r < 16; ++r) pA1[r] = __builtin_amdgcn_exp2f(pA1[r]);
    WAIT_BAR2(3, 2);
    if (4 < NT) { DMA_K(4, KS(4)); } DMA_V(2, VS(2));
#pragma unroll
    for (int j = 0; j < NF; ++j) kload2(kf, kp0 + KS(1), j);
    ENDW(0);
    s16x4 vlo[8], vhi[8]; u32x4 pw0, pw1, pw2, pw3;
#define PKW(P, B) cvtpk(P[B], P[B + 1])
#define PAF(k) __builtin_bit_cast(bf16x8, pw##k)
#define VFR(i) (bf16x8){vlo[i][0], vlo[i][1], vlo[i][2], vlo[i][3], vhi[i][0], vhi[i][1], vhi[i][2], vhi[i][3]}
#define PIN(x) asm volatile("" : "+v"(x))
#define MX3(a, b, c) __builtin_fmaxf(__builtin_fmaxf((a), (b)), (c))
#define GAPA(MF, A0, A1, A2, A3, W0, W1, PW) do { MF; sacc += A0; sacc += A1; sacc += A2; sacc += A3; PIN(sacc); W0; W1; PIN(PW); SBAR(); } while (0)
#define GAPM(MF) do { MF; SBAR(); } while (0)
#define EX(v) __builtin_amdgcn_exp2f(v)
#define GAPB(MF, X, B) do { MF; X[B] = EX(X[B]); X[B + 1] = EX(X[B + 1]); X[B + 2] = EX(X[B + 2]); X[B + 3] = EX(X[B + 3]); PIN(X); SBAR(); } while (0)
#define VRD(i) do { vlo[i] = vtr(vp_ + (((i) >> 2) * 4096 + ((i) & 3) * 1024)); vhi[i] = vtr(vp_ + (((i) >> 2) * 4096 + ((i) & 3) * 1024 + 512)); } while (0)
#define KRD(G, j) do { if (G) { kload2(kf, kpn_, j); SBAR(); } } while (0)
#define MF32(a, b, c) __builtin_amdgcn_mfma_f32_32x32x16_bf16(a, b, c, 0, 0, 0)
#define NAMASK(C0, C1, t) do { if (NA && (t) >= 4) { const int kr_ = krs + (t) - 4; const bool live_ = (kr_ >= rs) && (kr_ < rs + 8);        \
      asm volatile("s_nop 15\n\ts_nop 7" : "+v"(C0), "+v"(C1)); \
      if (!live_) { _Pragma("unroll") for (int r = 0; r < 16; ++r) { C0[r] = -INFINITY; C1[r] = -INFINITY; } } \
      else { const LAS float* br_ = biasL + (kr_ - qr_g + 7) * 31 + (15 - qc); \
        _Pragma("unroll") for (int r = 0; r < 16; ++r) { const int kc_ = crow(r, hi); const int c0_ = min(max(kc_, cs), cs + 15), c1_ = min(max(kc_ + 32, cs), cs + 15); \
            const float b0_ = br_[c0_], b1_ = br_[c1_]; C0[r] = (c0_ == kc_) ? C0[r] + b0_ : -INFINITY; C1[r] = (c1_ == kc_ + 32) ? C1[r] + b1_ : -INFINITY; } } } } while (0)
#define STEP(C0, C1, P0, P1, t, GK, GV, GL) do { SBAR(); \
    const lds_cptr vp_ = vp0 + VS((t) - 1); \
    VRD(0); SBAR(); float sacc = (P0[0] + P0[1]); \
    GAPA(C0 = MF32(kf[0], qr[0], negm), P0[2], P0[3], P0[4], P0[5],     pw0[0] = PKW(P0, 0), pw0[1] = PKW(P0, 2), pw0); \
    VRD(4); SBAR(); GAPA(C1 = MF32(kf[1], qr[0], negm), P0[6], P0[7], P0[8], P0[9],     pw0[2] = PKW(P0, 4), pw0[3] = PKW(P0, 6), pw0); \
    VRD(1); SBAR(); GAPA(C0 = MF32(kf[2], qr[1], C0),   P0[10], P0[11], P0[12], P0[13], pw1[0] = PKW(P0, 8), pw1[1] = PKW(P0, 10), pw1); \
    VRD(5); SBAR(); GAPA(C1 = MF32(kf[3], qr[1], C1),   P0[14], P0[15], P1[0], P1[1],   pw1[2] = PKW(P0, 12), pw1[3] = PKW(P0, 14), pw1); \
    VRD(2); SBAR(); GAPA(C0 = MF32(kf[4], qr[2], C0),   P1[2], P1[3], P1[4], P1[5],     pw2[0] = PKW(P1, 0), pw2[1] = PKW(P1, 2), pw2); \
    VRD(6); SBAR(); GAPA(C1 = MF32(kf[5], qr[2], C1),   P1[6], P1[7], P1[8], P1[9],     pw2[2] = PKW(P1, 4), pw2[3] = PKW(P1, 6), pw2); \
    VRD(3); SBAR(); GAPA(C0 = MF32(kf[6], qr[3], C0),   P1[10], P1[11], P1[12], P1[13], pw3[0] = PKW(P1, 8), pw3[1] = PKW(P1, 10), pw3); \
    VRD(7); SBAR(); GAPA(C1 = MF32(kf[7], qr[3], C1),   P1[14], P1[15], 0.f, 0.f,       pw3[2] = PKW(P1, 12), pw3[3] = PKW(P1, 14), pw3); \
    if constexpr (NF == 6) { GAPM(C0 = MF32(kf[2 * NF - 4], qr[NF - 2], C0)); GAPM(C1 = MF32(kf[2 * NF - 3], qr[NF - 2], C1)); GAPM(C0 = MF32(kf[2 * NF - 2], qr[NF - 1], C0)); GAPM(C1 = MF32(kf[2 * NF - 1], qr[NF - 1], C1)); } \
    l_reg += sacc; \
    if (GK) { DMA_K((t) + 4, KS(t)); } if (GV) { DMA_V((t) + 2, VS((t) + 2)); } const lds_cptr kpn_ = kp0 + KS((t) + 1); \
    NAMASK(C0, C1, t); \
    SBAR(); \
    GAPB(o[0] = MF32(PAF(0), VFR(0), o[0]), C0, 0); \
    GAPB(o[1] = MF32(PAF(0), VFR(4), o[1]), C0, 4); \
    KRD(GL, 0); GAPB(o[0] = MF32(PAF(1), VFR(1), o[0]), C0, 8); \
    KRD(GL, 1); GAPB(o[1] = MF32(PAF(1), VFR(5), o[1]), C0, 12); \
    KRD(GL, 2); GAPB(o[0] = MF32(PAF(2), VFR(2), o[0]), C1, 0); \
    KRD(GL, 3); GAPB(o[1] = MF32(PAF(2), VFR(6), o[1]), C1, 4); \
    if constexpr (NF == 6) { KRD(GL, NF - 2); } GAPB(o[0] = MF32(PAF(3), VFR(3), o[0]), C1, 8); \
    if constexpr (NF == 6) { KRD(GL, NF - 1); } GAPB(o[1] = MF32(PAF(3), VFR(7), o[1]), C1, 12); \
    } while (0)
    int t = 1;
    for (; t + 5 < NT; t += 2) {
        STEP(pB0, pB1, pA0, pA1, t, true, true, true);     WAIT_BAR2(6, 4); RESC(); ROT();
        STEP(pA0, pA1, pB0, pB1, t + 1, true, true, true); WAIT_BAR2(6, 4); RESC(); ROT();
    }
    for (; t + 1 < NT; t += 2) {
        STEP(pB0, pB1, pA0, pA1, t, (t + 4 < NT), (t + 2 < NT), (t + 1 < NT));         ENDW(t);     RESC(); ROT();
        STEP(pA0, pA1, pB0, pB1, t + 1, (t + 5 < NT), (t + 3 < NT), (t + 2 < NT));     ENDW(t + 1); RESC(); ROT();
    }
    STEP(pB0, pB1, pA0, pA1, NT - 1, false, false, false); RESC();
    { float sacc = pB0[0] + pB0[1];
#pragma unroll
      for (int r = 2; r < 16; ++r) sacc += pB0[r];
#pragma unroll
      for (int r = 0; r < 16; ++r) sacc += pB1[r];
      l_reg += sacc;
      pw0 = (u32x4){PKW(pB0, 0), PKW(pB0, 2), PKW(pB0, 4), PKW(pB0, 6)}; pw1 = (u32x4){PKW(pB0, 8), PKW(pB0, 10), PKW(pB0, 12), PKW(pB0, 14)};
      pw2 = (u32x4){PKW(pB1, 0), PKW(pB1, 2), PKW(pB1, 4), PKW(pB1, 6)}; pw3 = (u32x4){PKW(pB1, 8), PKW(pB1, 10), PKW(pB1, 12), PKW(pB1, 14)};
      SBAR(); pv(o, vb0 + VS(NT - 1), PAF(0), PAF(1), PAF(2), PAF(3)); }
    { auto rr = __builtin_amdgcn_permlane32_swap(__float_as_uint(l_reg), __float_as_uint(l_reg), false, false); l_reg = __uint_as_float(rr[0]) + __uint_as_float(rr[1]); }
    if (hi == 0) wsf[32 + r32] = l_reg; asm volatile("s_waitcnt lgkmcnt(0)" ::: "memory");
    float rli[16];
#pragma unroll
    for (int r = 0; r < 16; ++r) rli[r] = __builtin_amdgcn_rcpf(wsf[32 + crow(r, hi)]);
    bf16* Ow = Ow0 + (size_t)(wid * QBLK) * LDO;
    { LAS bf16* stg = (LAS bf16*)(shm + LDS_OST) + wid * 2048;
#pragma unroll
      for (int r = 0; r < 16; ++r) { const int orow = crow(r, hi);
#pragma unroll
        for (int d0 = 0; d0 < 2; ++d0) stg[orow * 64 + d0 * 32 + r32] = (bf16)(cvtpk(o[d0][r] * rli[r], 0.f) & 0xffffu); }
      asm volatile("s_waitcnt lgkmcnt(0)" ::: "memory");
#pragma unroll
      for (int i = 0; i < 4; ++i) { const int row = i * 8 + (lane >> 3), ch = lane & 7; const u32x4 v = *(const LAS u32x4*)(stg + row * 64 + ch * 8); *(u32x4*)(Ow + (size_t)row * LDO + ch * 8) = v; } }
    asm volatile("s_waitcnt lgkmcnt(0)\n\ts_barrier" ::: "memory");
#undef DMA_K
#undef DMA_V
#undef START
#undef RESC
#undef ROT
#undef KS
#undef VS
#undef ENDW
#undef PKW
#undef PAF
#undef VFR
#undef PIN
#undef MX3
#undef GAPA
#undef GAPM
#undef GAPB
#undef EX
#undef VRD
#undef KRD
#undef MF32
#undef NAMASK
#undef TROW
#undef STEP
}
#undef SBAR
#undef WAIT_BAR2
}

#define XB_TMO      128
#define XB_XCNT(j)  (256  + 64 * (j))
#define XB_XSUB(j)  (1280 + 64 * (j))
#define XB_XGEN(j)  (2304 + 64 * (j))
#define XB_TOP      3328
#define XB_TOPGEN   3392
#define XCD_BAR_WORDS 3456
#define XB_SPIN_CAP (1u << 22)
__device__ __forceinline__ unsigned xb_ld(unsigned* p)              { return __hip_atomic_load(p, __ATOMIC_RELAXED, __HIP_MEMORY_SCOPE_AGENT); }
__device__ __forceinline__ unsigned xb_add(unsigned* p, unsigned v) { return __hip_atomic_fetch_add(p, v, __ATOMIC_RELAXED, __HIP_MEMORY_SCOPE_AGENT); }
__device__ __forceinline__ unsigned xb_xcc_id() { return (unsigned)__builtin_amdgcn_s_getreg((3 << 11) | 20) & 0xFu; }
#define XB_SPIN(cond, bar) do { unsigned _sp = 0; while (cond) { __builtin_amdgcn_s_sleep(1); \
    if ((++_sp & 255u) == 0u) { if (xb_ld(&(bar)[XB_TMO])) break; if (_sp > XB_SPIN_CAP) { atomicAdd(&(bar)[XB_TMO], 1u); break; } } } } while (0)
struct XcdBarrier { unsigned* bar; unsigned x; volatile LAS unsigned* st; };
__device__ __forceinline__ XcdBarrier xcd_barrier_post(unsigned* bar, volatile LAS unsigned* st) {
    XcdBarrier b; b.bar = bar; b.x = xb_xcc_id(); b.st = st;
    if (threadIdx.x == 0) (void)xb_add(&bar[XB_XCNT(b.x)], 1u);
    return b;
}
__device__ __forceinline__ void xcd_barrier_complete(unsigned* bar, unsigned x, unsigned& nloc, unsigned& nx) {
    const unsigned G = gridDim.x * gridDim.y * gridDim.z;
    unsigned sum, cnt, mine, sp = 0u;
    for (;;) {
        sum = 0u; cnt = 0u; mine = 0u;
#pragma unroll
        for (unsigned j = 0; j < 16; ++j) { const unsigned c = xb_ld(&bar[XB_XCNT(j)]); sum += c; cnt += (c > 0u) ? 1u : 0u; mine = (j == x) ? c : mine; }
        if (sum == G) break;
        __builtin_amdgcn_s_sleep(1);
        if ((++sp & 255u) == 0u) { if (xb_ld(&bar[XB_TMO])) break; if (sp > XB_SPIN_CAP) { atomicAdd(&bar[XB_TMO], 1u); break; } }
    }
    nloc = mine > 0u ? mine : 1u; nx = cnt > 0u ? cnt : 1u;
}
__device__ __forceinline__ void xcd_barrier(const XcdBarrier& b) {
    asm volatile("s_waitcnt vmcnt(0)" ::: "memory");
    __syncthreads();
    int tid0_ = threadIdx.x; asm volatile("" : "+v"(tid0_));
    if (tid0_ == 0) {
        unsigned* bar = b.bar;
        __builtin_amdgcn_s_waitcnt(0);
        unsigned nloc = b.st[0], nx = b.st[1];
        if (nloc == 0u) { xcd_barrier_complete(bar, b.x, nloc, nx); b.st[0] = nloc; b.st[1] = nx; }
        const unsigned old = xb_add(&bar[XB_XSUB(b.x)], 1u);
        const unsigned gen = old / nloc;
        if (old + 1u == (gen + 1u) * nloc) {
            __builtin_amdgcn_fence(__ATOMIC_RELEASE, "agent");
            asm volatile("s_waitcnt vmcnt(0)" ::: "memory");
            const unsigned og = xb_add(&bar[XB_TOP], 1u);
            const unsigned tg = og / nx;
            if (og + 1u == (tg + 1u) * nx) xb_add(&bar[XB_TOPGEN], 1u);
            else XB_SPIN(xb_ld(&bar[XB_TOPGEN]) == tg, bar);
            __builtin_amdgcn_fence(__ATOMIC_ACQUIRE, "agent");
            xb_add(&bar[XB_XGEN(b.x)], 1u);
            asm volatile("s_waitcnt vmcnt(0)" ::: "memory");
        } else {
            XB_SPIN(xb_ld(&bar[XB_XGEN(b.x)]) == gen, bar);
            __builtin_amdgcn_fence(__ATOMIC_ACQUIRE, "agent");
            asm volatile("s_waitcnt vmcnt(0)" ::: "memory");
        }
    }
    __syncthreads();
}

constexpr int NWAVES = 8, NTHREADS = 512;
constexpr int RING_OFF = 0, RING_BYTES = 131072, LDSCTL_OFF = RING_BYTES, MISC_OFF = LDSCTL_OFF + 320, LDS_BYTES = 147456;
static_assert(mla::Lay<96>::LDS_BYTES <= RING_BYTES && mla::Lay<64>::LDS_BYTES <= RING_BYTES, "attention LDS");

struct Args { const float* in[26]; float* out; unsigned char* ws; int ph_lo, ph_hi; };
enum { I_X = 0, I_C, I_CTX, I_CCTX, I_MODW, I_MODB, I_LN1G, I_LN1B, I_LN2G, I_LN2B, I_WIN, I_RELB, I_QNORM, I_WQUP, I_KVNORM, I_WKVUP, I_WOUT, I_FG, I_FU, I_FD, I_POOLW, I_POOLS, I_ROUTER, I_MG, I_MU, I_MD };

struct Frame {
    LAS unsigned char* lds; int tid, lane, wave, vcu, G; unsigned char* ws; const float* const* in; float* out;
};
__device__ __forceinline__ const float* modv(const Frame& F, int layer, int s, int part) { return (const float*)(F.ws + WS_MODV) + ((size_t)(layer * 2 + s) * 6 + part) * D; }

__device__ __forceinline__ float kmax_q(const float* tab, int q, int lane) {
    const float* t = tab + q * 130; float m = fmaxf(t[lane], t[64 + lane]); if (lane < 2) m = fmaxf(m, t[128 + lane]);
#pragma unroll
    for (int o = 1; o < 64; o <<= 1) m = fmaxf(m, __shfl_xor(m, o));
    return m;
}
__device__ __forceinline__ int gu_row(int n0) { return (n0 >> 7) * 256 + (n0 & 127); }
constexpr int MOE_WE = 168, MOE_W = 8 * MOE_WE;
__device__ __forceinline__ unsigned pack4i8(float a, float b, float c, float d) {
    const int ia = (int)__builtin_rintf(a), ib = (int)__builtin_rintf(b), ic = (int)__builtin_rintf(c), id = (int)__builtin_rintf(d);
    return (unsigned)(ia & 255) | ((unsigned)(ib & 255) << 8) | ((unsigned)(ic & 255) << 16) | ((unsigned)id << 24);
}
__device__ __forceinline__ void conv_i8_strip(Frame& F, const float* W, int ldw, int n0, unsigned char* out8, int orow0, float* wsc, int nvalid = 64, float cs = 1.f) {
    LAS float* part = (LAS float*)(F.lds + RING_OFF + 12288);
    const bool live = F.lane < nvalid;
    const float* src = W + (size_t)(128 * F.wave) * ldw + n0 + (live ? F.lane : 0);
    const float csl = live ? cs : 0.f;
    float v[128]; float cm = 0.f;
#pragma unroll
    for (int i = 0; i < 128; ++i) v[i] = src[(size_t)i * ldw] * csl;
#pragma unroll
    for (int i = 0; i < 128; ++i) cm = fmaxf(cm, fabsf(v[i]));
#pragma unroll
    for (int o = 1; o < 64; o <<= 1) cm = fmaxf(cm, __shfl_xor(cm, o));
    part[F.wave * 64 + F.lane] = cm;
    __syncthreads();
#pragma unroll
    for (int w = 0; w < 8; ++w) cm = fmaxf(cm, part[w * 64 + F.lane]);
    const float sc = cm > 0.f ? 127.f / cm : 0.f;
    if (F.wave == 0) wsc[orow0 + F.lane] = cm * (1.f / 127.f);
    unsigned char* dst = out8 + (size_t)(orow0 + F.lane) * 1024 + 128 * F.wave;
#pragma unroll
    for (int g = 0; g < 8; ++g) { u32x4 o;
        o.x = pack4i8(v[16 * g] * sc, v[16 * g + 1] * sc, v[16 * g + 2] * sc, v[16 * g + 3] * sc); o.y = pack4i8(v[16 * g + 4] * sc, v[16 * g + 5] * sc, v[16 * g + 6] * sc, v[16 * g + 7] * sc);
        o.z = pack4i8(v[16 * g + 8] * sc, v[16 * g + 9] * sc, v[16 * g + 10] * sc, v[16 * g + 11] * sc); o.w = pack4i8(v[16 * g + 12] * sc, v[16 * g + 13] * sc, v[16 * g + 14] * sc, v[16 * g + 15] * sc);
        *(u32x4*)(dst + 16 * g) = o; }
    __syncthreads();
}
template <bool FP8>
__device__ __forceinline__ void conv_strip(const float* W, int ldw, int k0, int n0, void* out, int ldt, int orow0, int ocol0, const float* ks, const float* ns, float cs, int lane) {
    const float* src = W + (size_t)k0 * ldw + n0 + lane; const float nsv = (ns ? ns[n0 + lane] : 1.f) * cs;
    float v[128];
#pragma unroll
    for (int i = 0; i < 128; ++i) v[i] = src[(size_t)i * ldw] * nsv;
    if (ks) {
#pragma unroll
        for (int i = 0; i < 128; ++i) v[i] *= ks[k0 + i]; }
    if constexpr (FP8) { unsigned char* dst = (unsigned char*)out + (size_t)(orow0 + lane) * ldt + ocol0 + k0;
#pragma unroll
        for (int g = 0; g < 8; ++g) { int w[4];
#pragma unroll
            for (int q = 0; q < 4; ++q) { int t = 0; t = __builtin_amdgcn_cvt_pk_fp8_f32(v[16 * g + 4 * q], v[16 * g + 4 * q + 1], t, false); t = __builtin_amdgcn_cvt_pk_fp8_f32(v[16 * g + 4 * q + 2], v[16 * g + 4 * q + 3], t, true); w[q] = t; }
            *(u32x4*)(dst + 16 * g) = (u32x4){(unsigned)w[0], (unsigned)w[1], (unsigned)w[2], (unsigned)w[3]}; }
    } else { bf16* dst = (bf16*)out + (size_t)(orow0 + lane) * ldt + ocol0 + k0;
#pragma unroll
        for (int g = 0; g < 16; ++g) *(u32x4*)(dst + 8 * g) = (u32x4){cvtpk(v[8 * g], v[8 * g + 1]), cvtpk(v[8 * g + 2], v[8 * g + 3]), cvtpk(v[8 * g + 4], v[8 * g + 5]), cvtpk(v[8 * g + 6], v[8 * g + 7])}; }
}
constexpr int D_WQU = 24, D_WKV = 16, D_WOUT = 128, D_WDN = 352, D_POOL = 32, D_ALL = D_WQU + D_WKV + D_WOUT + D_WDN + D_POOL;
__device__ __forceinline__ void conv_dense_item(Frame& F, int j, int r) {
    if (r < D_WQU) { const int sb = r / 2, kb = r % 2; conv_strip<false>(F.in[I_WQUP] + (size_t)j * 256 * 768, 768, 128 * kb, 64 * sb, F.ws + WS_WUP + (size_t)j * 3 * MiB / 2, UP_K, 64 * sb, 0, F.in[I_QNORM] + j * 256, nullptr, QS_MLA, F.lane); return; } r -= D_WQU;
    if (r < D_WKV) { conv_strip<false>(F.in[I_WKVUP] + (size_t)j * 128 * 1024, 1024, 0, 64 * r, F.ws + WS_WUP + (size_t)j * 3 * MiB / 2, UP_K, 768 + 64 * r, 256, F.in[I_KVNORM] + j * 128, nullptr, 1.f, F.lane); return; } r -= D_WKV;
    if (r < D_WOUT) { const int sb = r / 8, kb = r % 8; conv_strip<false>(F.in[I_WOUT] + (size_t)j * D * D, D, 128 * kb, 64 * sb, F.ws + WS_WOUT + (size_t)j * D * D * 2, D, 64 * sb, 0, nullptr, nullptr, 1.f, F.lane); return; } r -= D_WOUT;
    if (r < D_WDN) { const int sb = r / 22, kb = r % 22; conv_strip<true>(F.in[I_FD] + (size_t)j * FFN * D, D, 128 * kb, 64 * sb, F.ws + WS_WDN + (size_t)j * 11 * MiB / 2, FFN, 64 * sb, 0, nullptr, nullptr, W8_SCALE, F.lane); return; } r -= D_WDN;
    { const int g = r / 8, q = r % 8, sb = q / 2, kb = q % 2; conv_strip<false>(F.in[I_POOLW] + (size_t)(j * 4 + g) * 65536, 256, 128 * kb, 64 * sb, F.ws + WS_WPOOL + (size_t)(j * 4 + g) * 65536 * 2, 256, 64 * sb, 0, nullptr, F.in[I_POOLS] + j * D + g * 256, 1.f, F.lane); }
}
__device__ __forceinline__ void conv_moedown_item(Frame& F, int j, int e, int q) {
    const int sb = q / 28, kb = q % 28;
    conv_strip<true>(F.in[I_MD] + (size_t)(j * 8 + e) * EDIM * D, D, 128 * kb, 64 * sb, F.ws + WS_MDN + (size_t)(j * 8 + e) * 7 * MiB, EDIM, 64 * sb, 0, nullptr, nullptr, W8_SCALE, F.lane);
}
__device__ __forceinline__ void moe_work(Frame& F, int j, int w) {
    const int e = w / MOE_WE, r = w % MOE_WE;
    if (r < 112) { const int up = r / 56, n0 = 64 * (r % 56);
        conv_i8_strip(F, F.in[up ? I_MU : I_MG] + (size_t)(j * 8 + e) * D * EDIM, EDIM, n0, F.ws + WS_MGU + (size_t)(j * 8 + e) * 7 * MiB, gu_row(n0) + up * 128, (float*)(F.ws + WS_WSCM) + (size_t)(j * 8 + e) * 7168);
    } else { const int c = r - 112; conv_moedown_item(F, j, e, c * 8 + F.wave); }
}
__device__ __forceinline__ void p0_prologue(Frame& F0) {
    Frame F = F0; { int t = threadIdx.x; asm volatile("" : "+v"(t)); F.tid = t; F.lane = t & 63; F.wave = __builtin_amdgcn_readfirstlane(t >> 6); }
    LAS float* scr = (LAS float*)(F.lds + RING_OFF + F.wave * 16384);
    const int gw = F.vcu * NWAVES + F.wave, NGW = F.G * NWAVES;
    {
        LAS float* sl = (LAS float*)(F.lds + 65536);
        LAS float* part = (LAS float*)(F.lds + 65536 + 8192);
        for (int it = blockIdx.x; it < 4 * 48; it += F.G) {
            const int layer = it / 48, ch = it % 48;
            for (int k = F.tid; k < 2048; k += NTHREADS) { const float v = (k < 1024) ? F.in[I_C][k] : F.in[I_CCTX][k - 1024]; sl[k] = v / (1.f + __expf(-v)); }
            __syncthreads();
            const float* W = F.in[I_MODW] + (size_t)layer * D * 6 * D + ch * 128 + 2 * F.lane;
            float a0 = 0.f, a1 = 0.f, b0 = 0.f, b1 = 0.f;
#pragma unroll 8
            for (int kk = 0; kk < 128; ++kk) { const int k = F.wave * 128 + kk; const f32x2 w = *(const f32x2*)(W + (size_t)k * 6 * D); const float sa = sl[k], sb = sl[1024 + k];
                a0 += sa * w[0]; a1 += sa * w[1]; b0 += sb * w[0]; b1 += sb * w[1]; }
            part[(F.wave * 2 + 0) * 128 + 2 * F.lane] = a0; part[(F.wave * 2 + 0) * 128 + 2 * F.lane + 1] = a1;
            part[(F.wave * 2 + 1) * 128 + 2 * F.lane] = b0; part[(F.wave * 2 + 1) * 128 + 2 * F.lane + 1] = b1;
            __syncthreads();
            if (F.tid < 256) { const int s = F.tid >> 7, cidx = F.tid & 127; float v = F.in[I_MODB][(size_t)layer * 6 * D + ch * 128 + cidx];
#pragma unroll
                for (int w = 0; w < 8; ++w) v += part[(w * 2 + s) * 128 + cidx];
                ((float*)(F.ws + WS_MODV))[(size_t)(layer * 2 + s) * 6 * D + ch * 128 + cidx] = v; }
            __syncthreads();
        }
    }
    if (blockIdx.x == F.G - 1) for (int i = F.tid; i < 2048; i += NTHREADS) { const int pos = i >> 3, f = i & 7; const double inv = exp(-log(10000.0) * (double)f / 8.0), ang = (double)pos * inv;
        float* t = (float*)(F.ws + WS_ROPE) + pos * 16; t[f] = (float)cos(ang); t[8 + f] = (float)sin(ang); }
    {
        const int gt = F.vcu * NTHREADS + F.tid, NGT = F.G * NTHREADS; const u32x4 z = {0u, 0u, 0u, 0u};
        constexpr int NZ_WIN = 64 * 64, NZ_A = 768 * 16, NZ_B = 1024 * 32, NZ = NZ_WIN + NZ_A + NZ_B;
        for (int i = gt; i < 2 * NZ; i += NGT) { const int j = i / NZ; int r = i % NZ;
            unsigned char* win = F.ws + WS_WIN + (size_t)j * 2048 * 1024; bf16* wup = (bf16*)(F.ws + WS_WUP + (size_t)j * 3 * MiB / 2);
            if (r < NZ_WIN) { *(u32x4*)(win + (size_t)(1984 + r / 64) * 1024 + (r % 64) * 16) = z; if (r < 64) ((float*)(F.ws + WS_WSCI))[j * 2048 + 1984 + r] = 0.f; continue; } r -= NZ_WIN;
            if (r < NZ_A) { *(u32x4*)(wup + (size_t)(r / 16) * UP_K + 256 + (r % 16) * 8) = z; continue; } r -= NZ_A;
            *(u32x4*)(wup + (size_t)(768 + r / 32) * UP_K + (r % 32) * 8) = z; }
    }
    { const int n0w = MOE_W, n1w = MOE_W;
      for (int it = blockIdx.x; it < 62; it += F.G) { const int j = it / 31, n0 = 64 * (it % 31);
          conv_i8_strip(F, F.in[I_WIN] + (size_t)j * D * IN_COLS, IN_COLS, n0, F.ws + WS_WIN + (size_t)j * 2048 * 1024, n0, (float*)(F.ws + WS_WSCI) + j * 2048, n0 + 64 <= IN_COLS ? 64 : IN_COLS - n0, n0 < 512 ? QS_NA : 1.f); }
      for (int it = blockIdx.x; it < 176 + n0w + n1w; it += F.G) {
        if (it < 176) { const int j = it / 88, q = it % 88, up = q / 44, n0 = 64 * (q % 44);
            conv_i8_strip(F, F.in[up ? I_FU : I_FG] + (size_t)j * D * FFN, FFN, n0, F.ws + WS_WGU + (size_t)j * 5632 * 1024, gu_row(n0) + up * 128, (float*)(F.ws + WS_WSC) + j * 5632); }
        else if (it - 176 < n0w) moe_work(F, 0, (MOE_W - n0w) + (it - 176));
        else moe_work(F, 1, (MOE_W - n1w) + (it - 176 - n0w)); } }
    for (int it = gw; it < 2 * D_ALL; it += NGW) conv_dense_item(F, it / D_ALL, it % D_ALL);
}

__device__ __forceinline__ void ld16(const float* p, int lane, float (&v)[16]) {
#pragma unroll
    for (int j = 0; j < 4; ++j) { const f32x4 t = *(const f32x4*)(p + 256 * j + 4 * lane); v[4 * j] = t[0]; v[4 * j + 1] = t[1]; v[4 * j + 2] = t[2]; v[4 * j + 3] = t[3]; }
}
__device__ __forceinline__ void st16(float* p, int lane, const float (&v)[16]) {
#pragma unroll
    for (int j = 0; j < 4; ++j) *(f32x4*)(p + 256 * j + 4 * lane) = (f32x4){v[4 * j], v[4 * j + 1], v[4 * j + 2], v[4 * j + 3]};
}
__device__ __forceinline__ void st16bf(bf16* p, int lane, const float (&v)[16]) {
#pragma unroll
    for (int j = 0; j < 4; ++j) *(u32x2*)(p + 256 * j + 4 * lane) = (u32x2){cvtpk(v[4 * j], v[4 * j + 1]), cvtpk(v[4 * j + 2], v[4 * j + 3])};
}
__device__ __forceinline__ void addbf16(const bf16* p, int lane, float (&v)[16]) {
#pragma unroll
    for (int j = 0; j < 4; ++j) { const u32x2 w = *(const u32x2*)(p + 256 * j + 4 * lane); v[4 * j] += bf_lo(w.x); v[4 * j + 1] += bf_hi(w.x); v[4 * j + 2] += bf_lo(w.y); v[4 * j + 3] += bf_hi(w.y); }
}
struct RowPass {
    const float* src_lat; const float* src_ctx;
    float* dst_lat; float* dst_ctx;
    bool do_ctx;
    bool skip_lat_store;
    const float* ln_g; const float* ln_b;
    const float* sh_lat; const float* sc_lat; const float* sh_ctx; const float* sc_ctx;
    bool write_h; bool h8; bool hi8; float* hsc; bf16* H;
    const float* g2_lat; const float* g2_ctx; const bf16* OUTm; const bf16* OUTm2; const int* rowslot; const unsigned* cnt;
    const float* router; int* rowslot_w; int* listTok; float* listW; unsigned* cnt_w;
};
template <bool DO_LN, bool MOE_IN, bool ROUTE>
__device__ __forceinline__ void row_pass(Frame& F0, const RowPass& P) {
    Frame F = F0; { int t = threadIdx.x; asm volatile("" : "+v"(t)); F.tid = t; F.lane = t & 63; F.wave = __builtin_amdgcn_readfirstlane(t >> 6); }
    LAS float* rt = (LAS float*)(F.lds);
    LAS int* selE = (LAS int*)(F.lds + 32768);
    LAS float* selW = (LAS float*)(F.lds + 32768 + 1024);
    LAS int* selR = (LAS int*)(F.lds + 32768 + 2048);
    int nsel = 0;
    if (ROUTE) { for (int i = F.tid; i < 8192; i += NTHREADS) rt[(i & 7) * 1024 + (i >> 3)] = P.router[i]; __syncthreads(); }
    int pb[8];
    if (MOE_IN) { int p = 0;
#pragma unroll
        for (int e = 0; e < 8; ++e) { const int n = (int)__hip_atomic_load(P.cnt + 64 * e, __ATOMIC_RELAXED, __HIP_MEMORY_SCOPE_AGENT); pb[e] = p; p += (n + 255) >> 8; } }
    float lg[16], lb[16];
    if (DO_LN) { ld16(P.ln_g, F.lane, lg); ld16(P.ln_b, F.lane, lb); }
    for (int s = P.do_ctx ? 0 : 1; s < 2; ++s) {
        const int n = s ? NLAT : NCTX, per = (n + F.G - 1) / F.G, r_lo = F.vcu * per, r_hi = min(r_lo + per, n);
        const float* src = s ? P.src_lat : P.src_ctx; float* dst = s ? P.dst_lat : P.dst_ctx;
        float sh[16], sc[16], g2[16];
        if (P.write_h) { ld16(s ? P.sh_lat : P.sh_ctx, F.lane, sh); ld16(s ? P.sc_lat : P.sc_ctx, F.lane, sc); }
        if (MOE_IN) ld16(s ? P.g2_lat : P.g2_ctx, F.lane, g2);
        for (int r = r_lo + F.wave; r < r_hi; r += NWAVES) {
            const int grow = s ? NCTX + r : r;
            float v[16]; ld16(src + (size_t)r * D, F.lane, v);
            if (MOE_IN) {
                const int e1 = P.rowslot[grow * 4 + 0], p1 = P.rowslot[grow * 4 + 1], e2 = P.rowslot[grow * 4 + 2], p2 = P.rowslot[grow * 4 + 3];
                int b1 = 0, b2 = 0;
#pragma unroll
                for (int e = 0; e < 8; ++e) { if (e1 == e) b1 = pb[e]; if (e2 == e) b2 = pb[e]; }
                float y[16];
#pragma unroll
                for (int i = 0; i < 16; ++i) y[i] = 0.f;
                addbf16(P.OUTm + (size_t)(b1 * 256 + p1) * D, F.lane, y); addbf16(P.OUTm + (size_t)(b2 * 256 + p2) * D, F.lane, y);
                addbf16(P.OUTm2 + (size_t)(b1 * 256 + p1) * D, F.lane, y); addbf16(P.OUTm2 + (size_t)(b2 * 256 + p2) * D, F.lane, y);
#pragma unroll
                for (int i = 0; i < 16; ++i) v[i] = v[i] * ALPHA + g2[i] * y[i];
            }
            if (DO_LN) {
                float sm = 0.f;
#pragma unroll
                for (int i = 0; i < 16; ++i) sm += v[i];
                const float mean = wave_sum(sm) * (1.f / D); float s2 = 0.f;
#pragma unroll
                for (int i = 0; i < 16; ++i) { v[i] -= mean; s2 += v[i] * v[i]; }
                const float rstd = rsqrtf(wave_sum(s2) * (1.f / D) + LN_EPS);
#pragma unroll
                for (int i = 0; i < 16; ++i) v[i] = v[i] * rstd * lg[i] + lb[i];
            }
            if (!(P.skip_lat_store && s == 1)) st16(dst + (size_t)r * D, F.lane, v);
            if (P.write_h) {
#pragma unroll
                for (int i = 0; i < 16; ++i) v[i] = v[i] * (1.f + sc[i]) + sh[i];
                if (P.hi8) { float am = 0.f;
#pragma unroll
                    for (int i = 0; i < 16; ++i) am = fmaxf(am, fabsf(v[i]));
#pragma unroll
                    for (int o = 1; o < 64; o <<= 1) am = fmaxf(am, __shfl_xor(am, o));
                    const float qs = am > 0.f ? 127.f / am : 0.f;
                    if (F.lane == 0) P.hsc[grow] = am * (1.f / 127.f);
#pragma unroll
                    for (int jj = 0; jj < 4; ++jj) *(unsigned*)((unsigned char*)P.H + (size_t)grow * D + 256 * jj + 4 * F.lane) = pack4i8(v[4 * jj] * qs, v[4 * jj + 1] * qs, v[4 * jj + 2] * qs, v[4 * jj + 3] * qs);
                } else if (P.h8) {
#pragma unroll
                    for (int jj = 0; jj < 4; ++jj) { int w = 0; w = __builtin_amdgcn_cvt_pk_fp8_f32(v[4 * jj], v[4 * jj + 1], w, false); w = __builtin_amdgcn_cvt_pk_fp8_f32(v[4 * jj + 2], v[4 * jj + 3], w, true);
                        *(int*)((unsigned char*)P.H + (size_t)grow * D + 256 * jj + 4 * F.lane) = w; }
                } else st16bf(P.H + (size_t)grow * D, F.lane, v);
                if (ROUTE) {
                    float lgt[8];
#pragma unroll
                    for (int e = 0; e < 8; ++e) { float a = 0.f;
#pragma unroll
                        for (int j = 0; j < 4; ++j) { const f32x4 w = *(const LAS f32x4*)(rt + e * 1024 + 256 * j + 4 * F.lane); a += v[4 * j] * w[0] + v[4 * j + 1] * w[1] + v[4 * j + 2] * w[2] + v[4 * j + 3] * w[3]; }
                        lgt[e] = wave_sum(a); }
                    int e1 = 0; float v1 = lgt[0];
#pragma unroll
                    for (int e = 1; e < 8; ++e) if (lgt[e] > v1) { v1 = lgt[e]; e1 = e; }
                    int e2 = -1; float v2 = -INFINITY;
#pragma unroll
                    for (int e = 0; e < 8; ++e) if (e != e1 && lgt[e] > v2) { v2 = lgt[e]; e2 = e; }
                    const float w1 = 1.f / (1.f + __expf(v2 - v1)), w2 = 1.f - w1;
                    const int slot = F.wave + 8 * nsel; ++nsel;
                    if (F.lane == 0) { selE[slot * 2] = e1; selE[slot * 2 + 1] = e2; selW[slot * 2] = w1; selW[slot * 2 + 1] = w2; selR[slot] = grow; }
                }
            }
        }
    }
    if (ROUTE) {
        LAS int* nselL = (LAS int*)(F.lds + 32768 + 3072);
        if (F.lane == 0) nselL[F.wave] = nsel;
        __syncthreads();
        if (F.tid < 8) { const int e = F.tid; int c = 0;
            for (int w = 0; w < 8; ++w) for (int k = 0; k < nselL[w]; ++k) { const int sl = w + 8 * k; c += (selE[sl * 2] == e) + (selE[sl * 2 + 1] == e); }
            int base = (int)__hip_atomic_fetch_add(P.cnt_w + 64 * e, (unsigned)c, __ATOMIC_RELAXED, __HIP_MEMORY_SCOPE_AGENT);
            for (int w = 0; w < 8; ++w) for (int k = 0; k < nselL[w]; ++k) { const int sl = w + 8 * k; const int grow = selR[sl];
                if (selE[sl * 2] == e) { P.listTok[(size_t)e * NTOK + base] = grow; P.listW[(size_t)e * NTOK + base] = selW[sl * 2]; P.rowslot_w[grow * 4 + 0] = e; P.rowslot_w[grow * 4 + 1] = base; ++base; }
                if (selE[sl * 2 + 1] == e) { P.listTok[(size_t)e * NTOK + base] = grow; P.listW[(size_t)e * NTOK + base] = selW[sl * 2 + 1]; P.rowslot_w[grow * 4 + 2] = e; P.rowslot_w[grow * 4 + 3] = base; ++base; } }
        }
        __syncthreads();
    }
}

template <bool FP8>
__device__ __forceinline__ void ctx_gemm_resid(Frame& F0, const void* A_, int lda, int acs, const void* Bt_, int ldb, int K, float* Xc, const float* gate, float sc = 1.f) {
    Frame F = F0; { int t = threadIdx.x; asm volatile("" : "+v"(t)); F.tid = t; F.lane = t & 63; F.wave = __builtin_amdgcn_readfirstlane(t >> 6); }
    LAS float* red = (LAS float*)(F.lds + RING_OFF);
    const int r32 = F.lane & 31, hi = F.lane >> 5;
    for (int tile = F.vcu; tile < 256; tile += F.G) {
        const int rb = tile >> 5, cb = tile & 31, row0 = 32 * rb, col0 = 32 * cb;
        f32x16 acc = {};
        const int nsteps = K / 128;
        if constexpr (FP8) {
            const unsigned char* ap = (const unsigned char*)A_ + (size_t)(row0 + r32) * lda + ((col0 >> 8) * acs) + 8 * hi;
            const unsigned char* bp = (const unsigned char*)Bt_ + (size_t)(col0 + r32) * ldb + 8 * hi;
#pragma unroll 2
            for (int i = 0; i < nsteps; i += 2) { const int k0 = (F.wave * nsteps + i) * 16;
                const long a0 = *(const long*)(ap + k0), b0 = *(const long*)(bp + k0), a1 = *(const long*)(ap + k0 + 16), b1 = *(const long*)(bp + k0 + 16);
                acc = __builtin_amdgcn_mfma_f32_32x32x16_fp8_fp8(a0, b0, acc, 0, 0, 0); acc = __builtin_amdgcn_mfma_f32_32x32x16_fp8_fp8(a1, b1, acc, 0, 0, 0); }
        } else {
            const bf16* ap = (const bf16*)A_ + (size_t)(row0 + r32) * lda + ((col0 >> 8) * acs) + 8 * hi;
            const bf16* bp = (const bf16*)Bt_ + (size_t)(col0 + r32) * ldb + 8 * hi;
#pragma unroll 2
            for (int i = 0; i < nsteps; i += 2) { const int k0 = (F.wave * nsteps + i) * 16;
                const bf16x8 a0 = *(const bf16x8*)(ap + k0), b0 = *(const bf16x8*)(bp + k0), a1 = *(const bf16x8*)(ap + k0 + 16), b1 = *(const bf16x8*)(bp + k0 + 16);
                acc = __builtin_amdgcn_mfma_f32_32x32x16_bf16(a0, b0, acc, 0, 0, 0); acc = __builtin_amdgcn_mfma_f32_32x32x16_bf16(a1, b1, acc, 0, 0, 0); }
        }
#pragma unroll
        for (int r = 0; r < 16; ++r) red[(F.wave * 16 + r) * 64 + F.lane] = acc[r];
        __syncthreads();
#pragma unroll
        for (int q = 0; q < 2; ++q) { const int o = F.tid + 512 * q, m = o >> 5, n = o & 31;
            const int h = (m >> 2) & 1, rg = (m & 3) + 4 * (m >> 3); float sum = 0.f;
#pragma unroll
            for (int w = 0; w < 8; ++w) sum += red[(w * 16 + rg) * 64 + n + 32 * h];
            float* xp = Xc + (size_t)(row0 + m) * D + col0 + n; *xp = *xp * ALPHA + gate[col0 + n] * (sum * sc); }
        __syncthreads();
    }
}
__device__ __forceinline__ void pool_pass(Frame& F0, const float* Xl, const float* Xc, bool do_ctx, const float* sc_lat, const float* sc_ctx, bf16* PM) {
    Frame F = F0; { int t = threadIdx.x; asm volatile("" : "+v"(t)); F.tid = t; F.lane = t & 63; F.wave = __builtin_amdgcn_readfirstlane(t >> 6); }
    const int hw = F.vcu * 2 + (F.tid >> 8), NHW = F.G * 2, c4 = (F.tid & 255) * 4, half = 1 << (c4 >> 8);
    const int nstrips = 512 + (do_ctx ? 8 : 0);
    for (int st = hw; st < nstrips; st += NHW) {
        const bool isl = st < 512; const int n = isl ? NLAT : NCTX, t0 = (isl ? st : st - 512) * 32;
        const float* X = (isl ? Xl : Xc) + c4; bf16* out = PM + (size_t)(isl ? NCTX : 0) * D + c4;
        const f32x4 scv = *(const f32x4*)((isl ? sc_lat : sc_ctx) + c4) + 1.f;
        f32x4 S = {0.f, 0.f, 0.f, 0.f};
        for (int tt = max(0, t0 - half); tt < min(n, t0 + half); ++tt) S += *(const f32x4*)(X + (size_t)tt * D);
        for (int t = t0; t < t0 + 32; ++t) {
            const int lo = max(0, t - half), hi = min(n, t + half);
            const f32x4 x = *(const f32x4*)(X + (size_t)t * D);
            const f32x4 m = (S * (1.f / (float)(hi - lo)) - x) * scv;
            *(u32x2*)(out + (size_t)t * D) = (u32x2){cvtpk(m[0], m[1]), cvtpk(m[2], m[3])};
            if (t + half < n) S += *(const f32x4*)(X + (size_t)(t + half) * D);
            if (t - half >= 0) S -= *(const f32x4*)(X + (size_t)(t - half) * D);
        }
    }
}
__device__ __forceinline__ void gather_pass(Frame& F0, const unsigned* cnt, const int* listTok, const bf16* H, bf16* AP, const float* hsc, float* hscm) {
    Frame F = F0; { int t = threadIdx.x; asm volatile("" : "+v"(t)); F.tid = t; F.lane = t & 63; F.wave = __builtin_amdgcn_readfirstlane(t >> 6); }
    int ne[8], pb[8], p = 0;
#pragma unroll
    for (int e = 0; e < 8; ++e) { ne[e] = (int)__hip_atomic_load(cnt + 64 * e, __ATOMIC_RELAXED, __HIP_MEMORY_SCOPE_AGENT); pb[e] = p; p += (ne[e] + 255) >> 8; }
    const int total = p * 256, gw = F.vcu * NWAVES + F.wave, NGW = F.G * NWAVES;
    for (int s = gw; s < total; s += NGW) {
        int es = 0, ps = 0, ns = 0;
#pragma unroll
        for (int e = 0; e < 8; ++e) if (s >= pb[e] * 256) { es = e; ps = s - pb[e] * 256; ns = ne[e]; }
        u32x4 a = {0u, 0u, 0u, 0u}; float hs = 0.f;
        if (ps < ns) { const int tok = listTok[(size_t)es * NTOK + ps]; a = ((const u32x4*)((const unsigned char*)H + (size_t)tok * D))[F.lane]; hs = hsc[tok]; }
        ((u32x4*)((unsigned char*)AP + (size_t)s * D))[F.lane] = a; if (F.lane == 0) hscm[s] = hs;
    }
}

constexpr int PH_PRO = 0, PH_INIT = 1, PH_BASE = 2, PH_PER_J = 15, PH_TOTAL = PH_BASE + 2 * PH_PER_J;

__global__ void __launch_bounds__(NTHREADS, 2) trunk_fwd(Args args) {
    extern __shared__ __attribute__((aligned(16))) unsigned char lds[];
    Frame F;
    F.lds = (LAS unsigned char*)lds; F.tid = threadIdx.x; F.lane = F.tid & 63; F.wave = __builtin_amdgcn_readfirstlane(F.tid >> 6);
    F.G = gridDim.x; { const int bx = blockIdx.x; F.vcu = (F.G % 8 == 0) ? (bx % 8) * (F.G / 8) + bx / 8 : bx; }
    F.ws = args.ws; F.in = args.in; F.out = args.out;
    unsigned* ctl = (unsigned*)(F.ws + WS_CTL);
    for (int u = F.tid; u < (LDS_BYTES - LDSCTL_OFF) / 4; u += NTHREADS) ((LAS unsigned*)(F.lds + LDSCTL_OFF))[u] = 0u;
    __syncthreads();
    const int lo = args.ph_lo, hi = args.ph_hi;
    const bool multi = (hi - lo) > 1;
    XcdBarrier bar; bar.bar = ctl + CW_BAR; bar.x = 0; bar.st = nullptr;
    if (multi) bar = xcd_barrier_post(ctl + CW_BAR, (volatile LAS unsigned*)(F.lds + MISC_OFF) + 8);
#define IN(k) (lo <= (k) && (k) < hi)
#define SEAM(k) do { if (IN(k) && IN((k) + 1)) xcd_barrier(bar); } while (0)
#define W_ring (F.lds + RING_OFF)
#define W_Xl (F.out)
#define W_Xc ((float*)(F.ws + WS_XC))
#define W_H ((bf16*)(F.ws + WS_H))
#define W_OB ((bf16*)(F.ws + WS_OB))
#define W_PROJ ((bf16*)(F.ws + WS_PROJ))
#define W_QM ((bf16*)(F.ws + WS_QM))
#define W_KM ((bf16*)(F.ws + WS_KM))
#define W_VM ((bf16*)(F.ws + WS_VM))
#define W_HID ((bf16*)(F.ws + WS_HID))
#define W_HIDM ((bf16*)(F.ws + WS_HIDM))
#define W_AP ((bf16*)(F.ws + WS_APERM))
#define W_SSQ ((float*)(F.ws + WS_SSQ))
#define W_rope ((const float*)(F.ws + WS_ROPE))
#define W_rowslot ((int*)(F.ws + WS_ROWSLOT))
#define W_listTok ((int*)(F.ws + WS_LISTTOK))
#define W_listW ((float*)(F.ws + WS_LISTW))

    if (EN(0) && IN(PH_PRO)) { p0_prologue(F); } SEAM(PH_PRO);
    if (EN(1) && IN(PH_INIT)) {
        RowPass P{}; P.src_lat = F.in[I_X]; P.src_ctx = F.in[I_CTX]; P.dst_lat = W_Xl; P.dst_ctx = W_Xc; P.do_ctx = true; P.skip_lat_store = true;
        P.sh_lat = modv(F, 0, 0, 0); P.sc_lat = modv(F, 0, 0, 1); P.sh_ctx = modv(F, 0, 1, 0); P.sc_ctx = modv(F, 0, 1, 1); P.write_h = true; P.hi8 = true; P.hsc = (float*)(F.ws + WS_HSC); P.H = W_H;
        row_pass<false, false, false>(F, P);
    } SEAM(PH_INIT);

    for (int j = 0; j < 2; ++j) {
        const int pe = PH_BASE + j * PH_PER_J, le = 2 * j, lod = 2 * j + 1;
        const bool ctx_e = (j == 0);
        const bool ctx_o = (j == 0);
        if (EN(2) && IN(pe + 0)) {
            pg8::DenseOrder S; S.init(65, 8, 0, F.G, (int)blockIdx.x, W_H, (size_t)256 * D, 0, F.ws + WS_WIN + (size_t)j * 2048 * 1024, (size_t)256 * 1024);
            pg8::EpiProj E{W_PROJ, W_SSQ, W_KM, W_rope, (float*)(F.ws + WS_KMAXP) + j * 33 * 130, (const float*)(F.ws + WS_HSC), (const float*)(F.ws + WS_WSCI) + j * 2048};
            pg8::gemm_phase<pg8::EpiProj, pg8::DenseOrder, 2>(W_ring, 512, 512, 512, S, E);
        } SEAM(pe + 0);
        if (EN(3) && IN(pe + 1)) {
            pg8::DenseOrder S; S.init(65, 7, 0, F.G, (int)blockIdx.x, W_PROJ + 1536, (size_t)256 * PROJ_LD * 2, 0, (const bf16*)(F.ws + WS_WUP + (size_t)j * 3 * MiB / 2), (size_t)256 * UP_K * 2);
            pg8::EpiUp E{W_SSQ, W_QM, W_KM, W_VM, W_rope, (float*)(F.ws + WS_KMAXP) + j * 33 * 130};
            pg8::gemm_phase(W_ring, UP_K, PROJ_LD, UP_K, S, E);
        } SEAM(pe + 1);
        if (EN(4) && IN(pe + 2)) {
            const int U = 1024 + (ctx_e ? 16 : 0);
            const float* relb = F.in[I_RELB] + (size_t)j * 8 * 465;
            for (int id = F.vcu; id < U; id += F.G) {
                const bool isctx = id >= 1024; const int x = id - 1024;
                const bool mla = isctx ? (x < 8) : (id < 512);
                const int id2 = id & 511, rem = id2 & 255;
                const int head = isctx ? (x & 7) : (rem >> 5), qb = (rem & 31) + 32 * (id2 >> 8);
                const size_t qrow = isctx ? 0 : (size_t)(NCTX + qb * 256);
                if (mla) {
                    const float* km = (const float*)(F.ws + WS_KMAXP) + j * 33 * 130;
                    const float k2 = kmax_q(km, 0, F.lane) + kmax_q(km, 1 + head * 2, F.lane) + kmax_q(km, 2 + head * 2, F.lane);
                    mla::attn_unit<96, false, QM_LD, KM_LD, VM_LD, D>(W_QM + qrow * QM_LD + head * 96, W_KM + head * 96, W_VM + head * 64, W_OB + qrow * D + 512 + head * 64, isctx ? 4 : NTOK / 64, k2, 0, 0, nullptr, (LAS char*)W_ring);
                } else {
                    const int R0 = 4 * qb, krs = min(min(max(R0 - 4, 0), 248), 244);
                    const bf16* Ph = W_PROJ + head * 64;
                    const float* km = (const float*)(F.ws + WS_KMAXP) + j * 33 * 130;
                    const float k2 = kmax_q(km, 17 + head * 2, F.lane) + kmax_q(km, 18 + head * 2, F.lane);
                    mla::attn_unit<64, true, PROJ_LD, PROJ_LD, PROJ_LD, D>(Ph + qrow * PROJ_LD, Ph + 512, Ph + 1024, W_OB + qrow * D + head * 64, isctx ? 4 : 16, k2, krs, R0, relb + head * 465, (LAS char*)W_ring);
                }
            }
        } SEAM(pe + 2);
        if (EN(5) && IN(pe + 3)) {
            pg8::DenseOrder S; S.init(64, 4, 1, F.G, (int)blockIdx.x, W_OB, (size_t)256 * D * 2, 0, (const bf16*)(F.ws + WS_WOUT) + (size_t)j * D * D, (size_t)256 * D * 2);
            pg8::EpiResid E{W_Xl, W_Xc, modv(F, le, 0, 2), modv(F, le, 1, 2), j == 0 ? F.in[I_X] : (const float*)W_Xl};
            pg8::gemm_phase(W_ring, 1024, 1024, 1024, S, E);
            if (ctx_e) ctx_gemm_resid<false>(F, W_OB, D, 0, (const bf16*)(F.ws + WS_WOUT) + (size_t)j * D * D, D, 1024, W_Xc, modv(F, le, 1, 2));
        } SEAM(pe + 3);
        if (EN(6) && IN(pe + 4)) {
            RowPass P{}; P.src_lat = W_Xl; P.src_ctx = W_Xc; P.dst_lat = W_Xl; P.dst_ctx = W_Xc; P.do_ctx = ctx_e; P.ln_g = F.in[I_LN1G] + le * D; P.ln_b = F.in[I_LN1B] + le * D;
            P.sh_lat = modv(F, le, 0, 3); P.sc_lat = modv(F, le, 0, 4); P.sh_ctx = modv(F, le, 1, 3); P.sc_ctx = modv(F, le, 1, 4); P.write_h = true; P.hi8 = true; P.hsc = (float*)(F.ws + WS_HSC); P.H = W_H;
            row_pass<true, false, false>(F, P);
        } SEAM(pe + 4);
        if (EN(7) && IN(pe + 5)) {
            pg8::DenseOrder S; S.init(ctx_e ? 65 : 64, 22, ctx_e ? 0 : 1, F.G, (int)blockIdx.x, W_H, (size_t)256 * D, 0, F.ws + WS_WGU + (size_t)j * 5632 * 1024, (size_t)256 * 1024);
            pg8::EpiSwigluI8 E{W_HID, FFN, (const float*)(F.ws + WS_HSC), (const float*)(F.ws + WS_WSC) + j * 5632, 0, true};
            pg8::gemm_phase<pg8::EpiSwigluI8, pg8::DenseOrder, 2>(W_ring, 512, 512, 512, S, E);
        } SEAM(pe + 5);
        if (EN(8) && IN(pe + 6)) {
            pg8::DenseOrder S; S.init(64, 4, 1, F.G, (int)blockIdx.x, W_HID, (size_t)256 * FFN, 0, F.ws + WS_WDN + (size_t)j * 11 * MiB / 2, (size_t)256 * FFN);
            pg8::EpiResid E{W_Xl, W_Xc, modv(F, le, 0, 5), modv(F, le, 1, 5), W_Xl, W8_INV};
            pg8::gemm_phase<pg8::EpiResid, pg8::DenseOrder, 1>(W_ring, FFN / 2, FFN / 2, FFN / 2, S, E);
            if (ctx_e) ctx_gemm_resid<true>(F, W_HID, FFN, 0, F.ws + WS_WDN + (size_t)j * 11 * MiB / 2, FFN, FFN, W_Xc, modv(F, le, 1, 5), W8_INV);
        } SEAM(pe + 6);
        if (EN(9) && IN(pe + 7)) {
            RowPass P{}; P.src_lat = W_Xl; P.src_ctx = W_Xc; P.dst_lat = W_Xl; P.dst_ctx = W_Xc; P.do_ctx = ctx_e; P.ln_g = F.in[I_LN2G] + le * D; P.ln_b = F.in[I_LN2B] + le * D; P.write_h = false;
            row_pass<true, false, false>(F, P);
        } SEAM(pe + 7);
        if (EN(10) && IN(pe + 8)) { pool_pass(F, W_Xl, W_Xc, ctx_o, modv(F, lod, 0, 1), modv(F, lod, 1, 1), W_OB); } SEAM(pe + 8);
        if (EN(11) && IN(pe + 9)) {
            pg8::DenseOrder S; S.init(64, 4, 1, F.G, (int)blockIdx.x, W_OB, (size_t)256 * D * 2, (size_t)256 * 2, (const bf16*)(F.ws + WS_WPOOL) + (size_t)j * 4 * 65536, (size_t)65536 * 2);
            pg8::EpiResid E{W_Xl, W_Xc, modv(F, lod, 0, 2), modv(F, lod, 1, 2), W_Xl};
            pg8::gemm_phase(W_ring, 256, 1024, 256, S, E);
            if (ctx_o) ctx_gemm_resid<false>(F, W_OB, D, 256, (const bf16*)(F.ws + WS_WPOOL) + (size_t)j * 4 * 65536, 256, 256, W_Xc, modv(F, lod, 1, 2));
        } SEAM(pe + 9);
        if (EN(12) && IN(pe + 10)) {
            RowPass P{}; P.src_lat = W_Xl; P.src_ctx = W_Xc; P.dst_lat = W_Xl; P.dst_ctx = W_Xc; P.do_ctx = ctx_o; P.ln_g = F.in[I_LN1G] + lod * D; P.ln_b = F.in[I_LN1B] + lod * D;
            P.sh_lat = modv(F, lod, 0, 3); P.sc_lat = modv(F, lod, 0, 4); P.sh_ctx = modv(F, lod, 1, 3); P.sc_ctx = modv(F, lod, 1, 4); P.write_h = true; P.hi8 = true; P.hsc = (float*)(F.ws + WS_HSC); P.H = W_H;
            P.router = F.in[I_ROUTER] + (size_t)j * D * 8; P.rowslot_w = W_rowslot; P.listTok = W_listTok; P.listW = W_listW; P.cnt_w = ctl + CW_CNT + j * 8 * 64;
            row_pass<true, false, true>(F, P);
        } SEAM(pe + 10);
        if (EN(13) && IN(pe + 11)) { gather_pass(F, ctl + CW_CNT + j * 8 * 64, W_listTok, W_H, W_AP, (const float*)(F.ws + WS_HSC), (float*)(F.ws + WS_HSCM)); } SEAM(pe + 11);
        if (EN(14) && IN(pe + 12)) {
            pg8::MoeOrder S; S.init(ctl + CW_CNT + j * 8 * 64, 28, F.G, F.vcu, W_AP, (size_t)256 * D, F.ws + WS_MGU + (size_t)j * 8 * 7 * MiB, (size_t)7 * MiB, (size_t)256 * 1024, 28, 0);
            pg8::EpiSwigluI8 E{W_HIDM, EDIM, (const float*)(F.ws + WS_HSCM), (const float*)(F.ws + WS_WSCM) + (size_t)j * 8 * 7168, 7168, true};
            pg8::gemm_phase<pg8::EpiSwigluI8, pg8::MoeOrder, 2>(W_ring, 512, 512, 512, S, E);
        } SEAM(pe + 12);
        if (EN(15) && IN(pe + 13)) {
            pg8::MoeOrder S; S.init(ctl + CW_CNT + j * 8 * 64, 8, F.G, F.vcu, W_HIDM, (size_t)256 * EDIM, F.ws + WS_MDN + (size_t)j * 8 * 7 * MiB, (size_t)7 * MiB, (size_t)256 * EDIM, 4, (size_t)(EDIM / 2));
            pg8::EpiMoeDown E{W_AP, (bf16*)(F.ws + WS_OUT2), W_listW, W8_INV};
            pg8::gemm_phase<pg8::EpiMoeDown, pg8::MoeOrder, 1>(W_ring, EDIM / 4, EDIM / 2, EDIM / 2, S, E);
        } SEAM(pe + 13);
        if (EN(16) && IN(pe + 14)) {
            RowPass P{}; P.src_lat = W_Xl; P.src_ctx = W_Xc; P.dst_lat = W_Xl; P.dst_ctx = W_Xc; P.do_ctx = ctx_o; P.ln_g = F.in[I_LN2G] + lod * D; P.ln_b = F.in[I_LN2B] + lod * D;
            P.write_h = (j == 0); if (j == 0) { P.sh_lat = modv(F, 2, 0, 0); P.sc_lat = modv(F, 2, 0, 1); P.sh_ctx = modv(F, 2, 1, 0); P.sc_ctx = modv(F, 2, 1, 1); } P.hi8 = true; P.hsc = (float*)(F.ws + WS_HSC); P.H = W_H;
            P.g2_lat = modv(F, lod, 0, 5); P.g2_ctx = modv(F, lod, 1, 5); P.OUTm = W_AP; P.OUTm2 = (const bf16*)(F.ws + WS_OUT2); P.rowslot = W_rowslot; P.cnt = ctl + CW_CNT + j * 8 * 64;
            row_pass<true, true, false>(F, P);
        } SEAM(pe + 14);
    }
#if PROBE_PHASE == 40
    if (IN(40)) {
        for (int id = F.vcu; id < 512; id += F.G) { const int rem = id & 255, head = rem >> 5, qb = (rem & 31) + 32 * (id >> 8); const size_t qrow = (size_t)(NCTX + qb * 256);
            mla::attn_unit<96, false, QM_LD, KM_LD, VM_LD, D>(W_QM + qrow * QM_LD + head * 96, W_KM + head * 96, W_VM + head * 64, W_OB + qrow * D + 512 + head * 64, NTOK / 64, 200.f, 0, 0, nullptr, (LAS char*)W_ring); } }
#endif
#if PROBE_PHASE == 41
    if (IN(41)) {
        const float* relb = F.in[I_RELB] + (size_t)8 * 465;
        for (int id = F.vcu; id < 512; id += F.G) { const int rem = id & 255, head = rem >> 5, qb = (rem & 31) + 32 * (id >> 8); const size_t qrow = (size_t)(NCTX + qb * 256);
            const int R0 = 4 * qb, krs = min(min(max(R0 - 4, 0), 248), 244); const bf16* Ph = W_PROJ + head * 64;
            mla::attn_unit<64, true, PROJ_LD, PROJ_LD, PROJ_LD, D>(Ph + qrow * PROJ_LD, Ph + 512, Ph + 1024, W_OB + qrow * D + head * 64, 16, 150.f, krs, R0, relb + head * 465, (LAS char*)W_ring); } }
#endif
#if PROBE_PHASE == 42
    if (IN(42)) {
        RowPass P{}; P.src_lat = W_Xl; P.src_ctx = W_Xc; P.dst_lat = (float*)(F.ws + WS_HIDM); P.dst_ctx = (float*)(F.ws + WS_HIDM) + (size_t)NLAT * D; P.do_ctx = true; P.ln_g = F.in[I_LN1G]; P.ln_b = F.in[I_LN1B];
        P.sh_lat = modv(F, 0, 0, 3); P.sc_lat = modv(F, 0, 0, 4); P.sh_ctx = modv(F, 0, 1, 3); P.sc_ctx = modv(F, 0, 1, 4); P.write_h = true; P.H = (bf16*)(F.ws + WS_HIDM + 80 * MiB);
        row_pass<true, false, false>(F, P); }
#endif
#if PROBE_PHASE == 43
    if (IN(43)) {
        RowPass P{}; P.src_lat = W_Xl; P.src_ctx = W_Xc; P.dst_lat = (float*)(F.ws + WS_HIDM); P.dst_ctx = (float*)(F.ws + WS_HIDM) + (size_t)NLAT * D; P.do_ctx = false; P.ln_g = F.in[I_LN2G]; P.ln_b = F.in[I_LN2B];
        P.write_h = false; P.g2_lat = modv(F, 3, 0, 5); P.g2_ctx = modv(F, 3, 1, 5); P.OUTm = W_AP; P.OUTm2 = (const bf16*)(F.ws + WS_OUT2); P.rowslot = W_rowslot; P.cnt = ctl + CW_CNT + 8 * 64;
        row_pass<true, true, false>(F, P); }
#endif
#if PROBE_PHASE == 45
    if (IN(45)) {
        RowPass P{}; P.src_lat = W_Xl; P.src_ctx = W_Xc; P.dst_lat = (float*)(F.ws + WS_HIDM); P.dst_ctx = (float*)(F.ws + WS_HIDM) + (size_t)NLAT * D; P.do_ctx = true; P.ln_g = F.in[I_LN1G]; P.ln_b = F.in[I_LN1B];
        P.sh_lat = modv(F, 1, 0, 3); P.sc_lat = modv(F, 1, 0, 4); P.sh_ctx = modv(F, 1, 1, 3); P.sc_ctx = modv(F, 1, 1, 4); P.write_h = true; P.h8 = true; P.H = (bf16*)(F.ws + WS_HIDM + 80 * MiB);
        P.router = F.in[I_ROUTER]; P.rowslot_w = (int*)(F.ws + WS_HIDM + 120 * MiB); P.listTok = (int*)(F.ws + WS_HIDM + 122 * MiB); P.listW = (float*)(F.ws + WS_HIDM + 124 * MiB); P.cnt_w = ctl + CW_CNT + 16 * 64;
        row_pass<true, false, true>(F, P); }
#endif
#if PROBE_PHASE == 46
    if (IN(46)) {
        pg8::DenseOrder S; S.init(64, 4, 1, F.G, (int)blockIdx.x, W_HID, (size_t)256 * FFN, 0, F.ws + WS_WDN, (size_t)256 * FFN);
        pg8::EpiResid E{(float*)(F.ws + WS_HIDM), (float*)(F.ws + WS_HIDM) + (size_t)NLAT * D, modv(F, 2, 0, 5), modv(F, 2, 1, 5), (const float*)(F.ws + WS_HIDM), W8_INV};
        pg8::gemm_phase<pg8::EpiResid, pg8::DenseOrder, 1>(W_ring, FFN / 2, FFN / 2, FFN / 2, S, E); }
#endif
#if PROBE_PHASE == 47
    if (IN(47)) {
        pg8::DenseOrder S; S.init(64, 4, 1, F.G, (int)blockIdx.x, W_OB, (size_t)256 * D * 2, 0, (const bf16*)(F.ws + WS_WOUT), (size_t)256 * D * 2);
        pg8::EpiResid E{(float*)(F.ws + WS_HIDM), (float*)(F.ws + WS_HIDM) + (size_t)NLAT * D, modv(F, 2, 0, 2), modv(F, 2, 1, 2), (const float*)(F.ws + WS_HIDM)};
        pg8::gemm_phase(W_ring, 1024, 1024, 1024, S, E); }
#endif
#if PROBE_PHASE == 48
    if (IN(48)) {
        pg8::DenseOrder S; S.init(64, 4, 1, F.G, (int)blockIdx.x, W_OB, (size_t)256 * D * 2, (size_t)256 * 2, (const bf16*)(F.ws + WS_WPOOL), (size_t)65536 * 2);
        pg8::EpiResid E{(float*)(F.ws + WS_HIDM), (float*)(F.ws + WS_HIDM) + (size_t)NLAT * D, modv(F, 3, 0, 2), modv(F, 3, 1, 2), (const float*)(F.ws + WS_HIDM)};
        pg8::gemm_phase(W_ring, 256, 1024, 256, S, E); }
#endif
#if PROBE_PHASE == 50
    _Pragma("clang loop unroll(disable)") for (int q = 50; q < 60; ++q) { SEAM(q); }
#endif
#if 0
#endif
#undef IN
#undef SEAM
}

extern "C" void kernel_launch(void* const* d_in, const int* in_sizes, int n_in, void* d_out, int out_size, void* d_ws, size_t ws_size, hipStream_t stream) {
    static int grid = 0;
    if (grid == 0) {
        if (n_in != 26 || out_size != NLAT * D || ws_size < WS_END) { fprintf(stderr, "kernel_launch: unexpected shapes: n_in %d out %d ws %zu (need %zu)\n", n_in, out_size, ws_size, (size_t)WS_END); grid = -1; return; }
        int dev = 0, cus = 0;
        if (hipGetDevice(&dev) != hipSuccess || hipDeviceGetAttribute(&cus, hipDeviceAttributeMultiprocessorCount, dev) != hipSuccess) { grid = -1; return; }
        if (hipFuncSetAttribute((const void*)trunk_fwd, hipFuncAttributeMaxDynamicSharedMemorySize, LDS_BYTES) != hipSuccess) { fprintf(stderr, "kernel_launch: hipFuncSetAttribute failed\n"); grid = -1; return; }
        (void)hipGetLastError();
        grid = cus;
    }
    if (grid < 0) return;
    if (hipMemsetAsync((char*)d_ws + WS_CTL, 0, CTL_ZERO_BYTES, stream) != hipSuccess) return;
    Args a{};
    for (int i = 0; i < 26; ++i) a.in[i] = (const float*)d_in[i];
    a.out = (float*)d_out; a.ws = (unsigned char*)d_ws;
#if ONE_LAUNCH
    a.ph_lo = 0; a.ph_hi = PH_TOTAL;
    hipLaunchKernelGGL(trunk_fwd, dim3(grid), dim3(NTHREADS), LDS_BYTES, stream, a);
    if (PROBE_PHASE >= 0) { (void)hipMemsetAsync((char*)d_ws + WS_CTL + CW_BAR * 4, 0, XCD_BAR_WORDS * 4, stream); a.ph_lo = PROBE_PHASE; a.ph_hi = PROBE_HI; hipLaunchKernelGGL(trunk_fwd, dim3(grid), dim3(NTHREADS), LDS_BYTES, stream, a); }
#else
    for (int p = 0; p < PH_TOTAL; ++p) { a.ph_lo = p; a.ph_hi = p + 1; hipLaunchKernelGGL(trunk_fwd, dim3(grid), dim3(NTHREADS), LDS_BYTES, stream, a); }
#endif
}
```

```cpp
#include <hip/hip_runtime.h>
#include <cstdio>
#include <cstdint>

#ifndef ONE_LAUNCH
#define ONE_LAUNCH 1
#endif
#ifndef PROBE_PHASE
#define PROBE_PHASE -1
#endif
#ifndef PROBE_HI
#define PROBE_HI (PROBE_PHASE + 1)
#endif
#ifndef PHASE_EN
#define PHASE_EN 0x1ffffu
#endif
#define EN(k) (((PHASE_EN) >> (k)) & 1u)

#define GAS __attribute__((address_space(1)))
#define LAS __attribute__((address_space(3)))
typedef unsigned short bf16;
typedef short bf16x8 __attribute__((ext_vector_type(8)));
typedef short s16x4 __attribute__((ext_vector_type(4)));
typedef float f32x2 __attribute__((ext_vector_type(2)));
typedef float f32x4 __attribute__((ext_vector_type(4)));
typedef float f32x16 __attribute__((ext_vector_type(16)));
typedef unsigned u32x2 __attribute__((ext_vector_type(2)));
typedef unsigned u32x4 __attribute__((ext_vector_type(4)));
typedef __bf16 bf16x2_t __attribute__((ext_vector_type(2)));

constexpr int D = 1024, NLAT = 16384, NCTX = 256, NTOK = NLAT + NCTX;
constexpr int GRID_W = 64;
constexpr int PROJ_LD = 2048, IN_COLS = 1952;
constexpr int QM_LD = 768, KM_LD = 768, VM_LD = 512;
constexpr int FFN = 2816, EDIM = 3584, NEXP = 8;
constexpr int UP_N = 1792, UP_K = 384;
constexpr float ALPHA = 1.681792830507429f;
constexpr float LOG2E = 1.4426950408889634f;
constexpr float QS_NA = 0.125f * LOG2E;
constexpr float QS_MLA = 0.10206207261596575f * LOG2E;
constexpr float LN_EPS = 1e-5f, RMS_EPS = 1e-6f;
constexpr int MAXPANELS = 138;
constexpr float W8_SCALE = 32.f, W8_INV = 1.f / 32.f;

constexpr size_t MiB = 1u << 20;
constexpr size_t WS_CTL = 0, CTL_ZERO_BYTES = 1 * MiB;
constexpr size_t WS_MODV = 1 * MiB;
constexpr size_t WS_ROPE = 1 * MiB + 256 * 1024;
constexpr size_t WS_WSCM = 1 * MiB + 512 * 1024;
constexpr size_t WS_XC = 2 * MiB;
constexpr size_t WS_SSQ = 3 * MiB;
constexpr size_t WS_HSCM = 4 * MiB + 512 * 1024;
constexpr size_t WS_KMAXP = 4 * MiB + 768 * 1024;
constexpr size_t WS_ROWSLOT = 5 * MiB;
constexpr size_t WS_LISTTOK = 6 * MiB;
constexpr size_t WS_LISTW = 7 * MiB;
constexpr size_t WS_WSC = 7 * MiB + 768 * 1024;
constexpr size_t WS_WSCI = 7 * MiB + 832 * 1024;
constexpr size_t WS_HSC = 7 * MiB + 896 * 1024;
constexpr size_t WS_WIN = 8 * MiB;
constexpr size_t WS_WUP = 16 * MiB;
constexpr size_t WS_WPOOL = 19 * MiB;
constexpr size_t WS_WOUT = 20 * MiB;
constexpr size_t WS_WGU = 24 * MiB;
constexpr size_t WS_WDN = 46 * MiB;
constexpr size_t WS_MGU = 58 * MiB;
constexpr size_t WS_MDN = 282 * MiB;
constexpr size_t WS_H = 394 * MiB;
constexpr size_t WS_OB = 427 * MiB;
constexpr size_t WS_PROJ = 460 * MiB;
constexpr size_t WS_QM = 525 * MiB;
constexpr size_t WS_KM = 550 * MiB;
constexpr size_t WS_VM = 575 * MiB;
constexpr size_t WS_HID = 592 * MiB;
constexpr size_t WS_HIDM = 460 * MiB;
constexpr size_t WS_APERM = 702 * MiB;
constexpr size_t WS_OUT2 = 772 * MiB;
constexpr size_t WS_END = 842 * MiB;
static_assert(WS_HID + (size_t)NTOK * FFN * 2 <= WS_APERM && WS_HIDM + (size_t)MAXPANELS * 256 * EDIM * 2 <= WS_APERM && WS_APERM + (size_t)MAXPANELS * 256 * D * 2 <= WS_OUT2 && WS_OUT2 + (size_t)MAXPANELS * 256 * D * 2 <= WS_END, "ws map");
static_assert(WS_MGU + 16 * 14 * MiB <= WS_MDN && WS_MDN + 16 * 7 * MiB <= WS_H && WS_H + (size_t)NTOK * D * 2 <= WS_OB && WS_OB + (size_t)NTOK * D * 2 <= WS_PROJ, "ws map 2");
static_assert(WS_PROJ + (size_t)NTOK * PROJ_LD * 2 <= WS_QM && WS_QM + (size_t)NTOK * QM_LD * 2 <= WS_KM && WS_KM + (size_t)NTOK * KM_LD * 2 <= WS_VM && WS_VM + (size_t)NTOK * VM_LD * 2 <= WS_HID, "ws map 3");
constexpr int CW_BAR = 4096;
constexpr int CW_CNT = 8192;
constexpr int CW_KMAX = 12288;

__device__ __forceinline__ unsigned cvtpk(float lo, float hi) { f32x2 v = {lo, hi}; bf16x2_t b = __builtin_convertvector(v, bf16x2_t); return __builtin_bit_cast(unsigned, b); }
__device__ __forceinline__ float bf_lo(unsigned w) { return __uint_as_float(w << 16); }
__device__ __forceinline__ float bf_hi(unsigned w) { return __uint_as_float(w & 0xffff0000u); }
__device__ __forceinline__ float wave_sum(float v) {
#pragma unroll
    for (int o = 1; o < 64; o <<= 1) v += __shfl_xor(v, o);
    return v;
}
#define LDS_WAIT() asm volatile("s_waitcnt lgkmcnt(0)" ::: "memory")
#define VM_WAIT() asm volatile("s_waitcnt vmcnt(0)" ::: "memory")

namespace pg8 {
constexpr int BM = 256, BK = 64, HALF = 128, HTB = HALF * BK * 2, STAGE_BYTES = 8 * HTB, NXCD = 8, WGM = 8;
__device__ __forceinline__ int lds_byte(int r, int c) { const int st = (r >> 4) * 2 + (c >> 5), rr = r & 15, cc = c & 31, ob = rr * 64 + cc * 2; return st * 1024 + (ob ^ (((ob >> 9) & 1) << 5)); }
__device__ __forceinline__ void stage_rc(int b, int& R, int& C) { const int st = b / 1024, sb = b % 1024, swz = sb ^ (((sb >> 9) & 1) << 5); R = (st >> 1) * 16 + swz / 64; C = (st & 1) * 32 + (swz % 64) / 2; }
__device__ __forceinline__ int perm32(int rho) { const int n = rho >> 4, i = rho & 15; return 8 * (i >> 2) + 4 * n + (i & 3); }

typedef int v8i32 __attribute__((ext_vector_type(8)));
typedef int v4i32 __attribute__((ext_vector_type(4)));
__device__ __forceinline__ v4i32 ifrag_lo(v8i32 f) { return __builtin_shufflevector(f, f, 0, 1, 2, 3); }
__device__ __forceinline__ v4i32 ifrag_hi(v8i32 f) { return __builtin_shufflevector(f, f, 4, 5, 6, 7); }
template <bool I8> struct AccSel { typedef f32x4 T; };
template <> struct AccSel<true> { typedef v4i32 T; };
__device__ __forceinline__ bf16x8 frag_lo(v8i32 f) { const v4i32 a = __builtin_shufflevector(f, f, 0, 1, 2, 3); return __builtin_bit_cast(bf16x8, a); }
__device__ __forceinline__ bf16x8 frag_hi(v8i32 f) { const v4i32 a = __builtin_shufflevector(f, f, 4, 5, 6, 7); return __builtin_bit_cast(bf16x8, a); }
struct Unit { int pm, pn, aux, p0, ne; const char* a; const char* b; };

struct DenseOrder {
    int nM, nN, nwg, G, c, pm0; const char* A; const char* B; size_t astep, acs, bstep;
    __device__ __forceinline__ void init(int nM_, int nN_, int pm0_, int G_, int c_, const void* A_, size_t astep_, size_t acs_, const void* B_, size_t bstep_) {
        asm volatile("" : "+s"(c_));
        nM = nM_; nN = nN_; nwg = nM * nN; G = G_; c = c_; pm0 = pm0_; A = (const char*)A_; B = (const char*)B_; astep = astep_; acs = acs_; bstep = bstep_; }
    __device__ __forceinline__ bool next(int i, Unit& u) const {
        const long L = (long)i * G + c; if (L >= nwg) return false;
        int wgid = (int)L; { const int q = nwg / NXCD, r = nwg % NXCD, xcd = wgid % NXCD, off = wgid / NXCD; wgid = (xcd < r ? xcd * (q + 1) : r * (q + 1) + (xcd - r) * q) + off; }
        const int nig = WGM * nN, gid = wgid / nig, fm = gid * WGM, gsz = (nM - fm) < WGM ? (nM - fm) : WGM;
        u.pm = pm0 + fm + ((wgid % nig) % gsz); u.pn = (wgid % nig) / gsz; u.aux = 0; u.p0 = 0; u.ne = 0;
        u.a = A + (size_t)u.pm * astep + (size_t)u.pn * acs; u.b = B + (size_t)u.pn * bstep; return true;
    }
};
struct MoeOrder {
    int np[8], pb[8], ne[8]; int total, nN, G, c, ncol; const char* A; const char* B; size_t astep, bexp, bstep, ksb;
    __device__ __forceinline__ void init(const unsigned* cnt, int nN_, int G_, int c_, const void* A_, size_t astep_, const void* B_, size_t bexp_, size_t bstep_, int ncol_, size_t ksb_) {
        ncol = ncol_; ksb = ksb_;
        int p = 0;
#pragma unroll
        for (int e = 0; e < 8; ++e) { const int n = (int)__hip_atomic_load(cnt + 64 * e, __ATOMIC_RELAXED, __HIP_MEMORY_SCOPE_AGENT); ne[e] = n; np[e] = (n + 255) >> 8; pb[e] = p; p += np[e]; }
        asm volatile("" : "+s"(c_));
        nN = nN_; total = p * nN; G = G_; c = c_; A = (const char*)A_; B = (const char*)B_; astep = astep_; bexp = bexp_; bstep = bstep_;
    }
    __device__ __forceinline__ bool next(int i, Unit& u) const {
        const int L = i * G + c; if (L >= total) return false;
        int es = 0, cums = 0, nps = 1, pbs = 0, nes = 0, cum = 0;
#pragma unroll
        for (int e = 0; e < 8; ++e) { const int cn = np[e] * nN; const bool in = (L >= cum) && (L < cum + cn); if (in) { es = e; cums = cum; nps = np[e]; pbs = pb[e]; nes = ne[e]; } cum += cn; }
        const int local = L - cums; int pn, pl;
        if (ksb) { pl = local / nN; pn = local - pl * nN; }
        else { pn = local / nps; pl = local - pn * nps; }
        const int ks = pn / ncol, pc = pn - ks * ncol;
        u.pm = pbs + pl; u.pn = pc; u.aux = es | (ks << 8); u.p0 = pl * 256; u.ne = nes;
        u.a = A + (size_t)u.pm * astep + (size_t)ks * ksb; u.b = B + (size_t)es * bexp + (size_t)pc * bstep + (size_t)ks * ksb; return true;
    }
};

template <class Epi, class Sched, int MODE = 0>
__device__ __forceinline__ void gemm_phase(LAS unsigned char* lds, const int K, const int lda, const int ldb, const Sched& S, const Epi& E) {
    constexpr bool FP8 = (MODE == 1), I8 = (MODE == 2);
    typedef typename AccSel<I8>::T acc_t;
    int tid_ = threadIdx.x; asm volatile("" : "+v"(tid_));
    const int tid = tid_, wid = __builtin_amdgcn_readfirstlane(tid >> 6), lane = tid & 63, wr = wid >> 2, wc = wid & 3, fr = lane & 15, fq = lane >> 4;
    int nt = K / BK; asm volatile("" : "+s"(nt));
    unsigned voffA[2], voffB[2];
#pragma unroll
    for (int i = 0; i < 2; ++i) { int R, C; stage_rc(tid * 16 + i * 8192, R, C); const int Rb = Epi::PERM ? ((R & ~31) + perm32(R & 31)) : R;
        voffA[i] = (unsigned)(R * lda + C) * 2u; voffB[i] = (unsigned)(Rb * ldb + C) * 2u; }
    const size_t kstep = (size_t)(BK * 2);
    const size_t hstepA = (size_t)HALF * lda * 2, hstepB = (size_t)HALF * ldb * 2;
    const unsigned ldsw = (unsigned)wid * 1024u;
    const int aoff = lds_byte(wr * 64 + fr, fq * 8), boff = lds_byte(wc * 32 + fr, fq * 8);
#define PG8_SA(b, h) (((b) * 2 + (h)) * HTB)
#define PG8_SB(b, h) ((4 + (b) * 2 + (h)) * HTB)
#define PG8_STAGE(bufoff, gbase, voff) do { _Pragma("unroll") for (int _i = 0; _i < 2; ++_i) \
        __builtin_amdgcn_global_load_lds((const unsigned*)((const char*)(gbase) + (voff)[_i]), (LAS unsigned*)(lds + (bufoff) + ldsw + _i * 8192), 16, 0, 0); } while (0)
#define PG8_LDA(dst, b, h) do { _Pragma("unroll") for (int m = 0; m < 4; ++m) { const v4i32 lo_ = *(const LAS v4i32*)(lds + PG8_SA(b, h) + aoff + m * 2048), hi_ = *(const LAS v4i32*)(lds + PG8_SA(b, h) + aoff + m * 2048 + 1024); dst[m] = __builtin_shufflevector(lo_, hi_, 0, 1, 2, 3, 4, 5, 6, 7); } } while (0)
#define PG8_LDB(dst, b, h) do { _Pragma("unroll") for (int n = 0; n < 2; ++n) { const v4i32 lo_ = *(const LAS v4i32*)(lds + PG8_SB(b, h) + boff + n * 2048), hi_ = *(const LAS v4i32*)(lds + PG8_SB(b, h) + boff + n * 2048 + 1024); dst[n] = __builtin_shufflevector(lo_, hi_, 0, 1, 2, 3, 4, 5, 6, 7); } } while (0)
#define PG8_MMA(ai, bj, At, Bt) do { __builtin_amdgcn_s_setprio(1); _Pragma("unroll") for (int m = 0; m < 4; ++m) _Pragma("unroll") for (int n = 0; n < 2; ++n) { \
        if constexpr (FP8) { asm volatile("v_mfma_scale_f32_16x16x128_f8f6f4 %0, %1, %2, %0, %3, %3 op_sel_hi:[0,0,0]" : "+v"(acc[ai][bj][m][n]) : "v"(Bt[n]), "v"(At[m]), "v"(one8)); } \
        else if constexpr (I8) { acc[ai][bj][m][n] = __builtin_amdgcn_mfma_i32_16x16x64_i8(ifrag_lo(Bt[n]), ifrag_lo(At[m]), acc[ai][bj][m][n], 0, 0, 0); \
               acc[ai][bj][m][n] = __builtin_amdgcn_mfma_i32_16x16x64_i8(ifrag_hi(Bt[n]), ifrag_hi(At[m]), acc[ai][bj][m][n], 0, 0, 0); } \
        else { acc[ai][bj][m][n] = __builtin_amdgcn_mfma_f32_16x16x32_bf16(frag_lo(Bt[n]), frag_lo(At[m]), acc[ai][bj][m][n], 0, 0, 0); \
               acc[ai][bj][m][n] = __builtin_amdgcn_mfma_f32_16x16x32_bf16(frag_hi(Bt[n]), frag_hi(At[m]), acc[ai][bj][m][n], 0, 0, 0); } } \
        __builtin_amdgcn_s_setprio(0); } while (0)
#define PG8_WAIT_V(n) asm volatile("s_waitcnt vmcnt(" #n ")" ::: "memory")
#define PG8_WAIT_L(n) asm volatile("s_waitcnt lgkmcnt(" #n ")" ::: "memory")
#define PG8_BAR __builtin_amdgcn_s_barrier()
#define PG8_SCHED __builtin_amdgcn_sched_barrier(0)
    Unit cur, nxt; int ui = 0;
    if (!S.next(0, cur)) return;
    acc_t acc[2][2][4][2];
#pragma unroll
    for (int a = 0; a < 2; ++a)
#pragma unroll
        for (int b = 0; b < 2; ++b)
#pragma unroll
            for (int m = 0; m < 4; ++m)
#pragma unroll
                for (int n = 0; n < 2; ++n) acc[a][b][m][n] = acc_t{};
    int one8 = 0x7f7f7f7f; asm volatile("" : "+v"(one8));
    v8i32 At[4], B0[2], B1[2];
    const char* cA = cur.a; const char* cB = cur.b;
    typename Epi::Pre pre = E.pre(cur, wr, wc, fr, fq);
    PG8_STAGE(PG8_SB(0, 0), cB, voffB); PG8_STAGE(PG8_SB(0, 1), cB + hstepB, voffB); PG8_STAGE(PG8_SA(0, 0), cA, voffA); PG8_STAGE(PG8_SA(0, 1), cA + hstepA, voffA);
    if (wr == 1) PG8_BAR;
    PG8_WAIT_V(2); PG8_BAR;
    PG8_STAGE(PG8_SB(1, 0), cB + kstep, voffB); PG8_STAGE(PG8_SA(1, 0), cA + kstep, voffA); PG8_STAGE(PG8_SB(1, 1), cB + hstepB + kstep, voffB);
    PG8_WAIT_V(6); PG8_BAR;
    for (;;) {
        const bool has_next = S.next(ui + 1, nxt);
        const char* nA = has_next ? nxt.a : cA; const char* nB = has_next ? nxt.b : cB;
        for (int t = 0; t < nt; t += 2) {
            const bool last = (t == nt - 2);
            const char* a1 = cA + (size_t)(t + 1) * kstep;
            const char* a2 = last ? nA : cA + (size_t)(t + 2) * kstep; const char* b2 = last ? nB : cB + (size_t)(t + 2) * kstep;
            const char* a3 = a2 + kstep; const char* b3 = b2 + kstep;
            PG8_LDB(B0, 0, 0); PG8_LDB(B1, 0, 1); PG8_SCHED; PG8_LDA(At, 0, 0); PG8_STAGE(PG8_SA(1, 1), a1 + hstepA, voffA);
            PG8_WAIT_V(8); PG8_WAIT_L(0); PG8_BAR; PG8_MMA(0, 0, At, B0); PG8_MMA(0, 1, At, B1); PG8_BAR; PG8_SCHED;
            PG8_LDA(At, 0, 1); PG8_STAGE(PG8_SB(0, 0), b2, voffB); PG8_STAGE(PG8_SB(0, 1), b2 + hstepB, voffB); PG8_STAGE(PG8_SA(0, 0), a2, voffA);
            PG8_WAIT_V(8); PG8_WAIT_L(0); PG8_BAR; PG8_MMA(1, 0, At, B0); PG8_MMA(1, 1, At, B1); PG8_BAR; PG8_SCHED;
            PG8_LDB(B0, 1, 0); PG8_LDB(B1, 1, 1); PG8_SCHED; PG8_LDA(At, 1, 0); PG8_STAGE(PG8_SA(0, 1), a2 + hstepA, voffA);
            PG8_WAIT_V(8); PG8_WAIT_L(0); PG8_BAR; PG8_MMA(0, 0, At, B0); PG8_MMA(0, 1, At, B1); PG8_BAR; PG8_SCHED;
            PG8_LDA(At, 1, 1); PG8_STAGE(PG8_SB(1, 0), b3, voffB); PG8_STAGE(PG8_SB(1, 1), b3 + hstepB, voffB); PG8_STAGE(PG8_SA(1, 0), a3, voffA);
            PG8_WAIT_V(8); PG8_WAIT_L(0); PG8_BAR; PG8_MMA(1, 0, At, B0); PG8_MMA(1, 1, At, B1); PG8_BAR; PG8_SCHED;
        }
        if constexpr (FP8) asm volatile("s_nop 15\n\ts_nop 7" ::: "memory");
        if (wr == 0) PG8_BAR;
        { int te_ = threadIdx.x; asm volatile("" : "+v"(te_));
          const int le_ = te_ & 63; E(acc, cur, wr, wc, le_ & 15, le_ >> 4, pre); }
        if (!has_next) break;
#pragma unroll
        for (int a = 0; a < 2; ++a)
#pragma unroll
            for (int b = 0; b < 2; ++b)
#pragma unroll
                for (int m = 0; m < 4; ++m)
#pragma unroll
                    for (int n = 0; n < 2; ++n) acc[a][b][m][n] = acc_t{};
        cur = nxt; cA = nA; cB = nB; ++ui; pre = E.pre(cur, wr, wc, fr, fq);
        if (wr == 1) PG8_BAR;
    }
    PG8_WAIT_V(0);
    PG8_BAR;
#undef PG8_SA
#undef PG8_SB
#undef PG8_STAGE
#undef PG8_LDA
#undef PG8_LDB
#undef PG8_MMA
#undef PG8_WAIT_V
#undef PG8_WAIT_L
#undef PG8_BAR
#undef PG8_SCHED
}

__device__ __forceinline__ u32x4 pack8(const f32x4 v0, const f32x4 v1) { u32x4 w; w.x = cvtpk(v0[0], v0[1]); w.y = cvtpk(v0[2], v0[3]); w.z = cvtpk(v1[0], v1[1]); w.w = cvtpk(v1[2], v1[3]); return w; }

__device__ __forceinline__ void rope8(f32x4& v0, f32x4& v1, int t, int fq, const float* rope) {
    const int pos = (fq < 2) ? (t >> 6) : (t & (GRID_W - 1));
    const float* tb = rope + pos * 16;
    const f32x4 c0 = *(const f32x4*)(tb), c1 = *(const f32x4*)(tb + 4), s0 = *(const f32x4*)(tb + 8), s1 = *(const f32x4*)(tb + 12);
    f32x4 u0, u1;
#pragma unroll
    for (int i = 0; i < 4; ++i) { u0[i] = __shfl_xor(v0[i], 16); u1[i] = __shfl_xor(v1[i], 16); }
    if (fq & 1) { v0 = u0 * s0 + v0 * c0; v1 = u1 * s1 + v1 * c1; }
    else        { v0 = v0 * c0 - u0 * s0; v1 = v1 * c1 - u1 * s1; }
}

struct EpiProj {
    static constexpr bool PERM = true;
    bf16* PROJ; float* SSQ; bf16* KM; const float* rope; float* kmax; const float* hsc; const float* wsc;
    struct Pre { float sw[2]; float hs[8]; };
    __device__ __forceinline__ Pre pre(const Unit& u, int wr, int wc, int fr, int fq) const {
        Pre p; const int wrow = u.pn * BM + wc * 32 + 8 * fq, row0 = u.pm * BM + wr * 64 + fr;
        p.sw[0] = wsc[wrow]; p.sw[1] = wsc[wrow + HALF];
#pragma unroll
        for (int q = 0; q < 8; ++q) p.hs[q] = hsc[row0 + (q >> 2) * HALF + (q & 3) * 16];
        return p;
    }
    __device__ __forceinline__ void operator()(const v4i32 (&acc)[2][2][4][2], const Unit& u, int wr, int wc, int fr, int fq, const Pre& p) const {
        const int row0 = u.pm * BM + wr * 64 + fr, col0 = u.pn * BM + wc * 32 + 8 * fq; float kr2 = 0.f, ka2[2] = {0.f, 0.f};
#pragma unroll
        for (int ai = 0; ai < 2; ++ai)
#pragma unroll
            for (int m = 0; m < 4; ++m) { const int row = row0 + ai * HALF + m * 16;
#pragma unroll
                for (int bj = 0; bj < 2; ++bj) { const float sc_ = p.hs[ai * 4 + m] * p.sw[bj];
                    f32x4 v0 = __builtin_convertvector(acc[ai][bj][m][0], f32x4) * sc_, v1 = __builtin_convertvector(acc[ai][bj][m][1], f32x4) * sc_;
                    *(u32x4*)(PROJ + (size_t)row * PROJ_LD + col0 + bj * HALF) = pack8(v0, v1);
                    if (u.pn == 2 || u.pn == 3) { float s2 = (v0[0] * v0[0] + v0[1] * v0[1]) + (v0[2] * v0[2] + v0[3] * v0[3]) + (v1[0] * v1[0] + v1[1] * v1[1]) + (v1[2] * v1[2] + v1[3] * v1[3]);
                        s2 += __shfl_xor(s2, 16); s2 += __shfl_xor(s2, 32); ka2[bj] = fmaxf(ka2[bj], s2); }
                    if (u.pn == 6 || (u.pn == 7 && bj == 0)) {
                        float ss = (v0[0] * v0[0] + v0[1] * v0[1]) + (v0[2] * v0[2] + v0[3] * v0[3]) + (v1[0] * v1[0] + v1[1] * v1[1]) + (v1[2] * v1[2] + v1[3] * v1[3]);
                        ss += __shfl_xor(ss, 16); ss += __shfl_xor(ss, 32);
                        if (fq == 0) SSQ[(size_t)row * 16 + (u.pn == 6 ? bj * 4 + wc : 8 + wc)] = ss;
                    }
                    if (u.pn == 7 && bj == 1 && wc == 0) {
                        { float s2 = (v0[0] * v0[0] + v0[1] * v0[1]) + (v0[2] * v0[2] + v0[3] * v0[3]) + (v1[0] * v1[0] + v1[1] * v1[1]) + (v1[2] * v1[2] + v1[3] * v1[3]);
                          s2 += __shfl_xor(s2, 16); s2 += __shfl_xor(s2, 32); kr2 = fmaxf(kr2, s2); }
                        if (u.pm >= 1) rope8(v0, v1, row - NCTX, fq, rope);
                        const u32x4 w = pack8(v0, v1);
#pragma unroll
                        for (int h = 0; h < 8; ++h) *(u32x4*)(KM + (size_t)row * KM_LD + h * 96 + 64 + 8 * fq) = w;
                    }
                } }
        if (u.pn == 2 || u.pn == 3) {
#pragma unroll
            for (int bj = 0; bj < 2; ++bj) { float m = ka2[bj];
#pragma unroll
                for (int o = 1; o < 16; o <<= 1) m = fmaxf(m, __shfl_xor(m, o));
                if ((fr | fq) == 0) kmax[(17 + ((u.pn - 2) * 4 + bj * 2 + (wc >> 1)) * 2 + (wc & 1)) * 130 + u.pm * 2 + wr] = m; }
        }
        if (u.pn == 7 && wc == 0) {
#pragma unroll
            for (int o = 1; o < 16; o <<= 1) kr2 = fmaxf(kr2, __shfl_xor(kr2, o));
            if ((fr | fq) == 0) kmax[u.pm * 2 + wr] = kr2;
        }
    }
};
struct EpiUp {
    static constexpr bool PERM = true;
    struct Pre {}; __device__ __forceinline__ Pre pre(const Unit&, int, int, int, int) const { return Pre{}; }
    const float* SSQ; bf16* QM; bf16* KM; bf16* VM; const float* rope; float* kmax;
    __device__ __forceinline__ void operator()(const f32x4 (&acc)[2][2][4][2], const Unit& u, int wr, int wc, int fr, int fq, const Pre&) const {
        const int row0 = u.pm * BM + wr * 64 + fr; const bool isq = u.pn < 3; float kn2[2] = {0.f, 0.f};
#pragma unroll
        for (int ai = 0; ai < 2; ++ai)
#pragma unroll
            for (int m = 0; m < 4; ++m) { const int row = row0 + ai * HALF + m * 16; float r;
                if (isq) { const f32x4 a = *(const f32x4*)(SSQ + (size_t)row * 16), b = *(const f32x4*)(SSQ + (size_t)row * 16 + 4);
                    r = rsqrtf(((a[0] + a[1]) + (a[2] + a[3]) + (b[0] + b[1]) + (b[2] + b[3])) * (1.f / 256.f) + RMS_EPS); }
                else { const f32x4 a = *(const f32x4*)(SSQ + (size_t)row * 16 + 8); r = rsqrtf(((a[0] + a[1]) + (a[2] + a[3])) * (1.f / 128.f) + RMS_EPS); }
#pragma unroll
                for (int bj = 0; bj < 2; ++bj) { const int grp = u.pn * BM + bj * HALF + wc * 32, c0 = grp + 8 * fq;
                    f32x4 v0 = acc[ai][bj][m][0] * r, v1 = acc[ai][bj][m][1] * r;
                    if (isq) { if ((grp % 96) == 64 && u.pm >= 1) rope8(v0, v1, row - NCTX, fq, rope);
                        *(u32x4*)(QM + (size_t)row * QM_LD + c0) = pack8(v0, v1); }
                    else { const int cc = c0 - 768, head = cc >> 7, within = cc & 127;
                        if (within < 64) { *(u32x4*)(KM + (size_t)row * KM_LD + head * 96 + within) = pack8(v0, v1);
                            float s2 = (v0[0] * v0[0] + v0[1] * v0[1]) + (v0[2] * v0[2] + v0[3] * v0[3]) + (v1[0] * v1[0] + v1[1] * v1[1]) + (v1[2] * v1[2] + v1[3] * v1[3]);
                            s2 += __shfl_xor(s2, 16); s2 += __shfl_xor(s2, 32); kn2[bj] = fmaxf(kn2[bj], s2); }
                        else *(u32x4*)(VM + (size_t)row * VM_LD + head * 64 + within - 64) = pack8(v0, v1); }
                } }
        if (!isq && wc < 2) {
#pragma unroll
            for (int bj = 0; bj < 2; ++bj) { float m = kn2[bj];
#pragma unroll
                for (int o = 1; o < 16; o <<= 1) m = fmaxf(m, __shfl_xor(m, o));
                if ((fr | fq) == 0) kmax[(1 + ((u.pn - 3) * 2 + bj) * 2 + wc) * 130 + u.pm * 2 + wr] = m; }
        }
    }
};
struct EpiResid {
    static constexpr bool PERM = false;
    struct Pre {}; __device__ __forceinline__ Pre pre(const Unit&, int, int, int, int) const { return Pre{}; }
    float* Xl; float* Xc; const float* gate_lat; const float* gate_ctx; const float* Xsrc;
    float sc = 1.f;
    __device__ __forceinline__ void operator()(const f32x4 (&acc)[2][2][4][2], const Unit& u, int wr, int wc, int fr, int fq, const Pre&) const {
        const bool isctx = (u.pm == 0);
        float* Xb = isctx ? Xc : Xl + (size_t)(u.pm - 1) * BM * D; const float* gv = isctx ? gate_ctx : gate_lat;
        const float* Xs = isctx ? Xc : Xsrc + (size_t)(u.pm - 1) * BM * D;
        const int col0 = u.pn * BM + wc * 32 + 4 * fq;
        f32x4 g[2][2];
#pragma unroll
        for (int bj = 0; bj < 2; ++bj)
#pragma unroll
            for (int n = 0; n < 2; ++n) g[bj][n] = *(const f32x4*)(gv + col0 + bj * HALF + n * 16) * sc;
#pragma unroll
        for (int ai = 0; ai < 2; ++ai)
#pragma unroll
            for (int m = 0; m < 4; ++m) { float* xr = Xb + (size_t)(ai * HALF + wr * 64 + m * 16 + fr) * D + col0; const float* xs = Xs + (size_t)(ai * HALF + wr * 64 + m * 16 + fr) * D + col0;
#pragma unroll
                for (int bj = 0; bj < 2; ++bj)
#pragma unroll
                    for (int n = 0; n < 2; ++n) { f32x4 x = *(const f32x4*)(xs + bj * HALF + n * 16); x = x * ALPHA + g[bj][n] * acc[ai][bj][m][n]; *(f32x4*)(xr + bj * HALF + n * 16) = x; }
                if (m & 1) asm volatile("" ::: "memory"); }
    }
};
__device__ __forceinline__ float swi(float g, float up) { return g * up * __builtin_amdgcn_rcpf(1.f + __builtin_amdgcn_exp2f(-g * LOG2E)); }
struct EpiSwigluI8 {
    static constexpr bool PERM = true;
    bf16* HID; int ldh; const float* hsc; const float* wsc0; int wstride; bool out8;
    struct Pre { float sg, su; float hs[8]; };
    __device__ __forceinline__ Pre pre(const Unit& u, int wr, int wc, int fr, int fq) const {
        Pre p; const float* wsc = wsc0 + (size_t)(u.aux & 255) * wstride; const int wrow = u.pn * BM + wc * 32 + 8 * fq, row0 = u.pm * BM + wr * 64 + fr;
        p.sg = wsc[wrow]; p.su = wsc[wrow + HALF];
#pragma unroll
        for (int q = 0; q < 8; ++q) p.hs[q] = hsc[row0 + (q >> 2) * HALF + (q & 3) * 16];
        return p;
    }
    __device__ __forceinline__ void operator()(const v4i32 (&acc)[2][2][4][2], const Unit& u, int wr, int wc, int fr, int fq, const Pre& p) const {
        const int row0 = u.pm * BM + wr * 64 + fr, col0 = u.pn * HALF + wc * 32 + 8 * fq;
#pragma unroll
        for (int ai = 0; ai < 2; ++ai)
#pragma unroll
            for (int m = 0; m < 4; ++m) { const int row = row0 + ai * HALF + m * 16; const float cg = p.hs[ai * 4 + m] * p.sg, cu = p.hs[ai * 4 + m] * p.su; f32x4 h0, h1;
                const f32x2 cgm = {-LOG2E * cg, -LOG2E * cg}, cgu = {cg * cu, cg * cu};
#pragma unroll
                for (int n = 0; n < 2; ++n)
#pragma unroll
                    for (int i = 0; i < 4; i += 2) { const f32x2 g2 = {(float)acc[ai][0][m][n][i], (float)acc[ai][0][m][n][i + 1]}, u2 = {(float)acc[ai][1][m][n][i], (float)acc[ai][1][m][n][i + 1]};
                        const f32x2 t = g2 * cgm; f32x2 d; d.x = __builtin_amdgcn_exp2f(t.x); d.y = __builtin_amdgcn_exp2f(t.y); d = d + 1.0f;
                        f32x2 r; r.x = __builtin_amdgcn_rcpf(d.x); r.y = __builtin_amdgcn_rcpf(d.y);
                        const f32x2 o2 = (g2 * u2) * (r * cgu);
                        if (n == 0) { h0[i] = o2.x; h0[i + 1] = o2.y; } else { h1[i] = o2.x; h1[i + 1] = o2.y; } }
                if (out8) { int a = 0, b = 0; a = __builtin_amdgcn_cvt_pk_fp8_f32(h0[0], h0[1], a, false); a = __builtin_amdgcn_cvt_pk_fp8_f32(h0[2], h0[3], a, true);
                    b = __builtin_amdgcn_cvt_pk_fp8_f32(h1[0], h1[1], b, false); b = __builtin_amdgcn_cvt_pk_fp8_f32(h1[2], h1[3], b, true);
                    *(u32x2*)((unsigned char*)HID + (size_t)row * ldh + col0) = (u32x2){(unsigned)a, (unsigned)b}; }
                else *(u32x4*)(HID + (size_t)row * ldh + col0) = pack8(h0, h1); }
    }
};
struct EpiMoeDown {
    static constexpr bool PERM = true;
    struct Pre {}; __device__ __forceinline__ Pre pre(const Unit&, int, int, int, int) const { return Pre{}; }
    bf16* OUT0; bf16* OUT1; const float* listW; float sc;
    __device__ __forceinline__ void operator()(const f32x4 (&acc)[2][2][4][2], const Unit& u, int wr, int wc, int fr, int fq, const Pre&) const {
        const int col0 = u.pn * BM + wc * 32 + 8 * fq; const int e = u.aux & 255; bf16* OUT = (u.aux >> 8) ? OUT1 : OUT0;
#pragma unroll
        for (int ai = 0; ai < 2; ++ai)
#pragma unroll
            for (int m = 0; m < 4; ++m) { const int r = ai * HALF + wr * 64 + m * 16 + fr, p = u.p0 + r;
                const float w = (p < u.ne) ? listW[(size_t)e * NTOK + p] * sc : 0.f;
#pragma unroll
                for (int bj = 0; bj < 2; ++bj) *(u32x4*)(OUT + (size_t)(u.pm * BM + r) * D + col0 + bj * HALF) = pack8(acc[ai][bj][m][0] * w, acc[ai][bj][m][1] * w); }
    }
};
}


namespace mla {
using f32x16_t = f32x16;
constexpr int NW = 8, QBLK = 32, KVBLK = 64;
constexpr int NSLOT = 3, VSLOT = 8192;
template <int DQK> struct Lay {
    static constexpr int KSLOT = 64 * DQK * 2, LDS_K = 0, LDS_V = NSLOT * KSLOT, LDS_WS = LDS_V + NSLOT * VSLOT, LDS_OST = LDS_WS + NW * 64 * 4, LDS_BIAS = LDS_OST + NW * 4096, LDS_BYTES = LDS_BIAS + 2048 + 64;
};
#define SBAR() __builtin_amdgcn_sched_barrier(0)
__device__ __forceinline__ int crow(int r, int hi) { return (r & 3) + 8 * (r >> 2) + 4 * hi; }
__device__ __forceinline__ void glds16(const void* gbase  , unsigned voff  , unsigned lds_dst) { unsigned keep;
    asm volatile("s_mov_b32 %0, m0\n\ts_mov_b32 m0, %2\n\ts_nop 0\n\tglobal_load_lds_dwordx4 %1, %3\n\ts_mov_b32 m0, %0" : "=&s"(keep) : "v"(voff), "s"(lds_dst), "s"(gbase) : "memory"); }
__device__ __forceinline__ float max3f(float a, float b, float c) { float r; asm("v_max3_f32 %0, %1, %2, %3" : "=v"(r) : "v"(a), "v"(b), "v"(c)); return r; }
__device__ __forceinline__ float max2f(float a, float b) { float r; asm("v_max_f32_e32 %0, %1, %2" : "=v"(r) : "v"(a), "v"(b)); return r; }
__device__ __forceinline__ float fadd_s(float a, float b) { float r; asm("v_add_f32_e32 %0, %1, %2" : "=v"(r) : "v"(a), "v"(b)); return r; }
__device__ __forceinline__ float fsub_s(float a, float b) { float r; asm("v_sub_f32_e32 %0, %1, %2" : "=v"(r) : "v"(a), "v"(b)); return r; }
#define WAIT_BAR2(NL, NO) do { if (lead) asm volatile("s_waitcnt vmcnt(" #NL ") lgkmcnt(0)\n\ts_barrier" ::: "memory"); else asm volatile("s_waitcnt vmcnt(" #NO ") lgkmcnt(0)\n\ts_barrier" ::: "memory"); } while (0)
typedef LAS const char* lds_cptr;
typedef short v4i16_t __attribute__((ext_vector_type(4)));
__device__ __forceinline__ void kload2(bf16x8* kf, lds_cptr kp, int j) { kf[2 * j] = *(const LAS bf16x8*)(kp + j * 2048); kf[2 * j + 1] = *(const LAS bf16x8*)(kp + j * 2048 + 512); }
__device__ __forceinline__ s16x4 vtr(lds_cptr p) { return __builtin_bit_cast(s16x4, __builtin_amdgcn_ds_read_tr16_b64_v4i16((LAS v4i16_t*)p)); }
__device__ __forceinline__ float rowmax(const f32x16& p0, const f32x16& p1) {
    float a = max3f(p0[0], p0[1], p1[0]), b = max3f(p0[2], p0[3], p1[1]); a = max3f(a, p1[2], p1[3]);
#pragma unroll
    for (int r = 4; r < 16; r += 4) { a = max3f(a, p0[r], p0[r + 1]); b = max3f(b, p0[r + 2], p0[r + 3]); a = max3f(a, p1[r], p1[r + 1]); b = max3f(b, p1[r + 2], p1[r + 3]); }
    const float m = max2f(a, b);
    auto rr = __builtin_amdgcn_permlane32_swap(__float_as_uint(m), __float_as_uint(m), false, false);
    return max2f(__uint_as_float(rr[0]), __uint_as_float(rr[1]));
}
__device__ __forceinline__ void pv(f32x16* o, unsigned vb, bf16x8 pa0, bf16x8 pa1, bf16x8 pa2, bf16x8 pa3) {
#pragma unroll
    for (int d0 = 0; d0 < 2; ++d0) { s16x4 lo[4], hi[4];
#pragma unroll
        for (int ks = 0; ks < 4; ++ks) {
            asm volatile("ds_read_b64_tr_b16 %0,%1 offset:%c2" : "=&v"(lo[ks]) : "v"(vb), "i"(d0 * 4096 + ks * 1024) : "memory");
            asm volatile("ds_read_b64_tr_b16 %0,%1 offset:%c2" : "=&v"(hi[ks]) : "v"(vb), "i"(d0 * 4096 + ks * 1024 + 512) : "memory"); }
        asm volatile("s_waitcnt lgkmcnt(0)" ::: "memory"); SBAR();
#define PK(k) (bf16x8){lo[k][0], lo[k][1], lo[k][2], lo[k][3], hi[k][0], hi[k][1], hi[k][2], hi[k][3]}
        o[d0] = __builtin_amdgcn_mfma_f32_32x32x16_bf16(pa0, PK(0), o[d0], 0, 0, 0);
        o[d0] = __builtin_amdgcn_mfma_f32_32x32x16_bf16(pa1, PK(1), o[d0], 0, 0, 0);
        o[d0] = __builtin_amdgcn_mfma_f32_32x32x16_bf16(pa2, PK(2), o[d0], 0, 0, 0);
        o[d0] = __builtin_amdgcn_mfma_f32_32x32x16_bf16(pa3, PK(3), o[d0], 0, 0, 0);
#undef PK
    }
}
template <int DQK, bool NA, int LDQ, int LDK, int LDV, int LDO>
__device__ __forceinline__ void attn_unit(const bf16* Qw0, const bf16* __restrict__ Kh, const bf16* __restrict__ Vh, bf16* Ow0, const int NT, const float k2max  ,
                                          const int krs, const int qgrow, const float* __restrict__ biasg, LAS char* shm) {
    typedef Lay<DQK> L; constexpr int NF = DQK / 16, KSLOT = L::KSLOT, LDS_K = L::LDS_K, LDS_V = L::LDS_V, LDS_WS = L::LDS_WS, LDS_OST = L::LDS_OST;
    int tid_ = threadIdx.x; asm volatile("" : "+v"(tid_));
    const int tid = tid_, lane = tid & 63, r32 = lane & 31, hi = lane >> 5; const int wid = __builtin_amdgcn_readfirstlane(tid >> 6);
    const bool lead = (DQK == 96) && (wid < 4);
    LAS float* biasL = (LAS float*)(shm + L::LDS_BIAS); LAS float* bmaxL = (LAS float*)(shm + L::LDS_BIAS + 2048);
    const int qr_g = qgrow + (wid >> 1), qc = 32 * (wid & 1) + r32, rs = min(max(qr_g - 4, 0), 248), cs = min(max(qc - 8, 0), 48);
    if (NA) { float bv = -INFINITY; if (tid < 465) { bv = biasg[tid] * LOG2E; biasL[tid] = bv; }
#pragma unroll
        for (int o = 1; o < 64; o <<= 1) bv = fmaxf(bv, __shfl_xor(bv, o));
        if (lane == 0) bmaxL[wid] = bv; }
    const bf16* Qw = Qw0 + (size_t)(wid * QBLK) * LDQ;
    const unsigned lds0 = (unsigned)(uintptr_t)shm;
    LAS float* wsf = (LAS float*)(shm + LDS_WS) + wid * 64;
    const unsigned koff = (unsigned)(lane * LDK + wid * 8) * 2u;
    const unsigned voff = (unsigned)((16 * (wid & 3) + (lane >> 2)) * LDV + (wid >> 2) * 32 + (lane & 3) * 8) * 2u;
    const unsigned kdst = lds0 + LDS_K + wid * 1024, vdst = lds0 + LDS_V + wid * 1024;
#define TROW(t) ((NA && (t) >= 4) ? (NCTX + 64 * (krs + (t) - 4)) : 64 * (t))
#define DMA_K(t, slot) do { const bf16* kb_ = Kh + (size_t)TROW(t) * LDK; glds16(kb_, koff, (unsigned)__builtin_amdgcn_readfirstlane(kdst + (slot))); \
        if (lead) glds16(kb_ + 64, koff, (unsigned)__builtin_amdgcn_readfirstlane(kdst + 8192 + (slot))); } while (0)
#define DMA_V(t, vslot) glds16(Vh + (size_t)TROW(t) * LDV, voff, (unsigned)__builtin_amdgcn_readfirstlane(vdst + (vslot)))
    const unsigned vb0 = lds0 + LDS_V + ((lane >> 4) & 1) * 32 + (lane & 3) * 8 + (4 * hi + ((lane & 15) >> 2)) * 64;
    const LAS char* Kbase = shm + LDS_K; bf16x8 kf[2 * NF];
    const lds_cptr shm3 = (lds_cptr)shm; const lds_cptr kp0 = shm3 + LDS_K + hi * 1024 + r32 * 16;
    const lds_cptr vp0 = shm3 + LDS_V + ((lane >> 4) & 1) * 32 + (lane & 3) * 8 + (4 * hi + ((lane & 15) >> 2)) * 64;
    DMA_K(0, 0); DMA_V(0, 0); DMA_K(1, KSLOT);
    bf16x8 qr[NF];
#pragma unroll
    for (int d0 = 0; d0 < NF; ++d0) qr[d0] = *(const bf16x8*)(&Qw[(size_t)r32 * LDQ + d0 * 16 + hi * 8]);
    float l_reg = 0.f; f32x16 o[2]; o[0] = f32x16{}; o[1] = f32x16{}; f32x16 negm;
    float q2 = 0.f;
#pragma unroll
    for (int d0 = 0; d0 < NF; ++d0) { const u32x4 w = __builtin_bit_cast(u32x4, qr[d0]);
#pragma unroll
      for (int i = 0; i < 4; ++i) { const float a = bf_lo(w[i]), c = bf_hi(w[i]); q2 += a * a + c * c; } }
    { auto rr = __builtin_amdgcn_permlane32_swap(__float_as_uint(q2), __float_as_uint(q2), false, false); q2 = __uint_as_float(rr[0]) + __uint_as_float(rr[1]); }
#define START(P0, P1) do { _Pragma("unroll") for (int r = 0; r < 16; ++r) P0[r] = __builtin_amdgcn_exp2f(P0[r]); } while (0)
#define RESC() do { } while (0)
    f32x16 pA0, pA1, pB0, pB1;
    int ks_prev = 0, ks_cur = 0, ks_next = KSLOT, vs_prev = 0, vs_cur = 0, vs_next = VSLOT;
#define ROT() do { ks_prev = ks_cur; ks_cur = ks_next; ks_next = (ks_next == (NSLOT - 1) * KSLOT) ? 0 : ks_next + KSLOT; \
                   vs_prev = vs_cur; vs_cur = vs_next; vs_next = (vs_next == (NSLOT - 1) * VSLOT) ? 0 : vs_next + VSLOT; } while (0)
    DMA_K(2, 2 * KSLOT);
    WAIT_BAR2(5, 3);
    { float mref = sqrtf(q2 * k2max) * 1.01f + 0.01f;
      if (NA) { float bm = bmaxL[0];
#pragma unroll
        for (int w = 1; w < 8; ++w) bm = fmaxf(bm, bmaxL[w]);
        mref += fmaxf(bm, 0.f); }
      mref = fminf(mref, 100.f);
#pragma unroll
      for (int r = 0; r < 16; ++r) negm[r] = -mref;
      asm volatile("" : "+v"(negm)); }
    { const LAS char* kb = Kbase + hi * 1024 + r32 * 16;
#pragma unroll
      for (int d0 = 0; d0 < NF; ++d0) { const bf16x8 b0 = *(const LAS bf16x8*)(kb + d0 * 2048); const bf16x8 b1 = *(const LAS bf16x8*)(kb + d0 * 2048 + 512);
        if (d0 == 0) { pA0 = __builtin_amdgcn_mfma_f32_32x32x16_bf16(b0, qr[0], negm, 0, 0, 0); pA1 = __builtin_amdgcn_mfma_f32_32x32x16_bf16(b1, qr[0], negm, 0, 0, 0); }
        else { pA0 = __builtin_amdgcn_mfma_f32_32x32x16_bf16(b0, qr[d0], pA0, 0, 0, 0); pA1 = __builtin_amdgcn_mfma_f32_32x32x16_bf16(b1, qr[d0], pA1, 0, 0, 0); } } }
    asm volatile("s_nop 15\n\ts_nop 7" : "+v"(pA0), "+v"(pA1));
    START(pA0, pA1);
#pragma unroll
    for (int r = 0; r < 16; ++r) pA1[r] = __builtin_amdgcn_exp2f(pA1[r]);
    WAIT_BAR2(0, 0);
    DMA_K(3, 0); DMA_V(1, VSLOT);
    ROT();
#pragma unroll
    for (int j = 0; j < NF; ++j) kload2(kf, kp0 + ks_cur, j);
    WAIT_BAR2(3, 2);
    s16x4 vlo[8], vhi[8]; u32x4 pw0, pw1, pw2, pw3;
#define PKW(P, B) cvtpk(P[B], P[B + 1])
#define PAF(k) __builtin_bit_cast(bf16x8, pw##k)
#define VFR(i) (bf16x8){vlo[i][0], vlo[i][1], vlo[i][2], vlo[i][3], vhi[i][0], vhi[i][1], vhi[i][2], vhi[i][3]}
#define PIN(x) asm volatile("" : "+v"(x))
#define MX3(a, b, c) __builtin_fmaxf(__builtin_fmaxf((a), (b)), (c))
#define GAPA(MF, A0, A1, A2, A3, W0, W1, PW) do { MF; sacc += A0; sacc += A1; sacc += A2; sacc += A3; PIN(sacc); W0; W1; PIN(PW); SBAR(); } while (0)
#define GAPM(MF) do { MF; SBAR(); } while (0)
#define EX(v) __builtin_amdgcn_exp2f(v)
#define GAPB(MF, X, B) do { MF; X[B] = EX(X[B]); X[B + 1] = EX(X[B + 1]); X[B + 2] = EX(X[B + 2]); X[B + 3] = EX(X[B + 3]); PIN(X); SBAR(); } while (0)
#define VRD(i) do { vlo[i] = vtr(vp_ + (((i) >> 2) * 4096 + ((i) & 3) * 1024)); vhi[i] = vtr(vp_ + (((i) >> 2) * 4096 + ((i) & 3) * 1024 + 512)); } while (0)
#define KRD(G, j) do { if (G) { kload2(kf, kp0 + ks_next, j); SBAR(); } } while (0)
#define MF32(a, b, c) __builtin_amdgcn_mfma_f32_32x32x16_bf16(a, b, c, 0, 0, 0)
#define NAMASK(C0, C1, t) do { if (NA && (t) >= 4) { const int kr_ = krs + (t) - 4; const bool live_ = (kr_ >= rs) && (kr_ < rs + 8);        \
      asm volatile("s_nop 15\n\ts_nop 7" : "+v"(C0), "+v"(C1)); \
      if (!live_) { _Pragma("unroll") for (int r = 0; r < 16; ++r) { C0[r] = -INFINITY; C1[r] = -INFINITY; } } \
      else { const LAS float* br_ = biasL + (kr_ - qr_g + 7) * 31 + (15 - qc); \
        _Pragma("unroll") for (int r = 0; r < 16; ++r) { const int kc_ = crow(r, hi); const int c0_ = min(max(kc_, cs), cs + 15), c1_ = min(max(kc_ + 32, cs), cs + 15); \
            const float b0_ = br_[c0_], b1_ = br_[c1_]; C0[r] = (c0_ == kc_) ? C0[r] + b0_ : -INFINITY; C1[r] = (c1_ == kc_ + 32) ? C1[r] + b1_ : -INFINITY; } } } } while (0)
#define STEP(C0, C1, P0, P1, t, GK, GV, GL) do { SBAR(); \
    const lds_cptr vp_ = vp0 + vs_prev; \
    VRD(0); SBAR(); float sacc = (P0[0] + P0[1]); \
    GAPA(C0 = MF32(kf[0], qr[0], negm), P0[2], P0[3], P0[4], P0[5],     pw0[0] = PKW(P0, 0), pw0[1] = PKW(P0, 2), pw0); \
    VRD(4); SBAR(); GAPA(C1 = MF32(kf[1], qr[0], negm), P0[6], P0[7], P0[8], P0[9],     pw0[2] = PKW(P0, 4), pw0[3] = PKW(P0, 6), pw0); \
    VRD(1); SBAR(); GAPA(C0 = MF32(kf[2], qr[1], C0),   P0[10], P0[11], P0[12], P0[13], pw1[0] = PKW(P0, 8), pw1[1] = PKW(P0, 10), pw1); \
    VRD(5); SBAR(); GAPA(C1 = MF32(kf[3], qr[1], C1),   P0[14], P0[15], P1[0], P1[1],   pw1[2] = PKW(P0, 12), pw1[3] = PKW(P0, 14), pw1); \
    VRD(2); SBAR(); GAPA(C0 = MF32(kf[4], qr[2], C0),   P1[2], P1[3], P1[4], P1[5],     pw2[0] = PKW(P1, 0), pw2[1] = PKW(P1, 2), pw2); \
    VRD(6); SBAR(); GAPA(C1 = MF32(kf[5], qr[2], C1),   P1[6], P1[7], P1[8], P1[9],     pw2[2] = PKW(P1, 4), pw2[3] = PKW(P1, 6), pw2); \
    VRD(3); SBAR(); GAPA(C0 = MF32(kf[6], qr[3], C0),   P1[10], P1[11], P1[12], P1[13], pw3[0] = PKW(P1, 8), pw3[1] = PKW(P1, 10), pw3); \
    VRD(7); SBAR(); GAPA(C1 = MF32(kf[7], qr[3], C1),   P1[14], P1[15], 0.f, 0.f,       pw3[2] = PKW(P1, 12), pw3[3] = PKW(P1, 14), pw3); \
    if constexpr (NF == 6) { GAPM(C0 = MF32(kf[2 * NF - 4], qr[NF - 2], C0)); GAPM(C1 = MF32(kf[2 * NF - 3], qr[NF - 2], C1)); GAPM(C0 = MF32(kf[2 * NF - 2], qr[NF - 1], C0)); GAPM(C1 = MF32(kf[2 * NF - 1], qr[NF - 1], C1)); } \
    l_reg += sacc; \
    if (GK) { DMA_K((t) + 3, ks_cur); } if (GV) { DMA_V((t) + 1, vs_next); } \
    NAMASK(C0, C1, t); \
    SBAR(); \
    GAPB(o[0] = MF32(PAF(0), VFR(0), o[0]), C0, 0); \
    GAPB(o[1] = MF32(PAF(0), VFR(4), o[1]), C0, 4); \
    KRD(GL, 0); GAPB(o[0] = MF32(PAF(1), VFR(1), o[0]), C0, 8); \
    KRD(GL, 1); GAPB(o[1] = MF32(PAF(1), VFR(5), o[1]), C0, 12); \
    KRD(GL, 2); GAPB(o[0] = MF32(PAF(2), VFR(2), o[0]), C1, 0); \
    KRD(GL, 3); GAPB(o[1] = MF32(PAF(2), VFR(6), o[1]), C1, 4); \
    if constexpr (NF == 6) { KRD(GL, NF - 2); } GAPB(o[0] = MF32(PAF(3), VFR(3), o[0]), C1, 8); \
    if constexpr (NF == 6) { KRD(GL, NF - 1); } GAPB(o[1] = MF32(PAF(3), VFR(7), o[1]), C1, 12); \
    } while (0)
    int t = 1;
    for (; t + 5 < NT; t += 2) {
        STEP(pB0, pB1, pA0, pA1, t, true, true, true);     WAIT_BAR2(3, 2); RESC(); ROT();
        STEP(pA0, pA1, pB0, pB1, t + 1, true, true, true); WAIT_BAR2(3, 2); RESC(); ROT();
    }
#define ENDW(tt) do { if ((tt) + 3 < NT) { WAIT_BAR2(3, 2); } else if ((tt) + 2 < NT) { WAIT_BAR2(1, 1); } else { WAIT_BAR2(0, 0); } } while (0)
    for (; t + 1 < NT; t += 2) {
        STEP(pB0, pB1, pA0, pA1, t, (t + 3 < NT), (t + 1 < NT), (t + 1 < NT));         ENDW(t);     RESC(); ROT();
        STEP(pA0, pA1, pB0, pB1, t + 1, (t + 4 < NT), (t + 2 < NT), (t + 2 < NT));     ENDW(t + 1); RESC(); ROT();
    }
    STEP(pB0, pB1, pA0, pA1, NT - 1, false, false, false); RESC();
    { float sacc = pB0[0] + pB0[1];
#pragma unroll
      for (int r = 2; r < 16; ++r) sacc += pB0[r];
#pragma unroll
      for (int r = 0; r < 16; ++r) sacc += pB1[r];
      l_reg += sacc;
      pw0 = (u32x4){PKW(pB0, 0), PKW(pB0, 2), PKW(pB0, 4), PKW(pB0, 6)}; pw1 = (u32x4){PKW(pB0, 8), PKW(pB0, 10), PKW(pB0, 12), PKW(pB0, 14)};
      pw2 = (u32x4){PKW(pB1, 0), PKW(pB1, 2), PKW(pB1, 4), PKW(pB1, 6)}; pw3 = (u32x4){PKW(pB1, 8), PKW(pB1, 10), PKW(pB1, 12), PKW(pB1, 14)};
      SBAR(); pv(o, vb0 + vs_cur, PAF(0), PAF(1), PAF(2), PAF(3)); }
    { auto rr = __builtin_amdgcn_permlane32_swap(__float_as_uint(l_reg), __float_as_uint(l_reg), false, false); l_reg = __uint_as_float(rr[0]) + __uint_as_float(rr[1]); }
    if (hi == 0) wsf[32 + r32] = l_reg; asm volatile("s_waitcnt lgkmcnt(0)" ::: "memory");
    float rli[16];
#pragma unroll
    for (int r = 0; r < 16; ++r) rli[r] = __builtin_amdgcn_rcpf(wsf[32 + crow(r, hi)]);
    bf16* Ow = Ow0 + (size_t)(wid * QBLK) * LDO;
    { LAS bf16* stg = (LAS bf16*)(shm + LDS_OST) + wid * 2048;
#pragma unroll
      for (int r = 0; r < 16; ++r) { const int orow = crow(r, hi);
#pragma unroll
        for (int d0 = 0; d0 < 2; ++d0) stg[orow * 64 + d0 * 32 + r32] = (bf16)(cvtpk(o[d0][r] * rli[r], 0.f) & 0xffffu); }
      asm volatile("s_waitcnt lgkmcnt(0)" ::: "memory");
#pragma unroll
      for (int i = 0; i < 4; ++i) { const int row = i * 8 + (lane >> 3), ch = lane & 7; const u32x4 v = *(const LAS u32x4*)(stg + row * 64 + ch * 8); *(u32x4*)(Ow + (size_t)row * LDO + ch * 8) = v; } }
    asm volatile("s_waitcnt lgkmcnt(0)\n\ts_barrier" ::: "memory");
#undef DMA_K
#undef DMA_V
#undef START
#undef RESC
#undef ROT
#undef PKW
#undef PAF
#undef VFR
#undef PIN
#undef MX3
#undef GAPA
#undef GAPM
#undef GAPB
#undef EX
#undef VRD
#undef KRD
#undef MF32
#undef NAMASK
#undef TROW
#undef STEP
#undef ENDW
}
#undef SBAR
#undef WAIT_BAR2
}

#define XB_TMO      128
#define XB_XCNT(j)  (256  + 64 * (j))
#define XB_XSUB(j)  (1280 + 64 * (j))
#define XB_XGEN(j)  (2304 + 64 * (j))
#define XB_TOP      3328
#define XB_TOPGEN   3392
#define XCD_BAR_WORDS 3456
#define XB_SPIN_CAP (1u << 22)
__device__ __forceinline__ unsigned xb_ld(unsigned* p)              { return __hip_atomic_load(p, __ATOMIC_RELAXED, __HIP_MEMORY_SCOPE_AGENT); }
__device__ __forceinline__ unsigned xb_add(unsigned* p, unsigned v) { return __hip_atomic_fetch_add(p, v, __ATOMIC_RELAXED, __HIP_MEMORY_SCOPE_AGENT); }
__device__ __forceinline__ unsigned xb_xcc_id() { return (unsigned)__builtin_amdgcn_s_getreg((3 << 11) | 20) & 0xFu; }
#define XB_SPIN(cond, bar) do { unsigned _sp = 0; while (cond) { __builtin_amdgcn_s_sleep(1); \
    if ((++_sp & 255u) == 0u) { if (xb_ld(&(bar)[XB_TMO])) break; if (_sp > XB_SPIN_CAP) { atomicAdd(&(bar)[XB_TMO], 1u); break; } } } } while (0)
struct XcdBarrier { unsigned* bar; unsigned x; volatile LAS unsigned* st; };
__device__ __forceinline__ XcdBarrier xcd_barrier_post(unsigned* bar, volatile LAS unsigned* st) {
    XcdBarrier b; b.bar = bar; b.x = xb_xcc_id(); b.st = st;
    if (threadIdx.x == 0) (void)xb_add(&bar[XB_XCNT(b.x)], 1u);
    return b;
}
__device__ __forceinline__ void xcd_barrier_complete(unsigned* bar, unsigned x, unsigned& nloc, unsigned& nx) {
    const unsigned G = gridDim.x * gridDim.y * gridDim.z;
    unsigned sum, cnt, mine, sp = 0u;
    for (;;) {
        sum = 0u; cnt = 0u; mine = 0u;
#pragma unroll
        for (unsigned j = 0; j < 16; ++j) { const unsigned c = xb_ld(&bar[XB_XCNT(j)]); sum += c; cnt += (c > 0u) ? 1u : 0u; mine = (j == x) ? c : mine; }
        if (sum == G) break;
        __builtin_amdgcn_s_sleep(1);
        if ((++sp & 255u) == 0u) { if (xb_ld(&bar[XB_TMO])) break; if (sp > XB_SPIN_CAP) { atomicAdd(&bar[XB_TMO], 1u); break; } }
    }
    nloc = mine > 0u ? mine : 1u; nx = cnt > 0u ? cnt : 1u;
}
__device__ __forceinline__ void xcd_barrier(const XcdBarrier& b) {
    asm volatile("s_waitcnt vmcnt(0)" ::: "memory");
    __syncthreads();
    int tid0_ = threadIdx.x; asm volatile("" : "+v"(tid0_));
    if (tid0_ == 0) {
        unsigned* bar = b.bar;
        __builtin_amdgcn_s_waitcnt(0);
        unsigned nloc = b.st[0], nx = b.st[1];
        if (nloc == 0u) { xcd_barrier_complete(bar, b.x, nloc, nx); b.st[0] = nloc; b.st[1] = nx; }
        const unsigned old = xb_add(&bar[XB_XSUB(b.x)], 1u);
        const unsigned gen = old / nloc;
        if (old + 1u == (gen + 1u) * nloc) {
            __builtin_amdgcn_fence(__ATOMIC_RELEASE, "agent");
            asm volatile("s_waitcnt vmcnt(0)" ::: "memory");
            const unsigned og = xb_add(&bar[XB_TOP], 1u);
            const unsigned tg = og / nx;
            if (og + 1u == (tg + 1u) * nx) xb_add(&bar[XB_TOPGEN], 1u);
            else XB_SPIN(xb_ld(&bar[XB_TOPGEN]) == tg, bar);
            __builtin_amdgcn_fence(__ATOMIC_ACQUIRE, "agent");
            xb_add(&bar[XB_XGEN(b.x)], 1u);
            asm volatile("s_waitcnt vmcnt(0)" ::: "memory");
        } else {
            XB_SPIN(xb_ld(&bar[XB_XGEN(b.x)]) == gen, bar);
            __builtin_amdgcn_fence(__ATOMIC_ACQUIRE, "agent");
            asm volatile("s_waitcnt vmcnt(0)" ::: "memory");
        }
    }
    __syncthreads();
}

constexpr int NWAVES = 8, NTHREADS = 512;
constexpr int RING_OFF = 0, RING_BYTES = 131072, LDSCTL_OFF = RING_BYTES, MISC_OFF = LDSCTL_OFF + 320, LDS_BYTES = 147456;
static_assert(mla::Lay<96>::LDS_BYTES <= RING_BYTES && mla::Lay<64>::LDS_BYTES <= RING_BYTES, "attention LDS");

struct Args { const float* in[26]; float* out; unsigned char* ws; int ph_lo, ph_hi; };
enum { I_X = 0, I_C, I_CTX, I_CCTX, I_MODW, I_MODB, I_LN1G, I_LN1B, I_LN2G, I_LN2B, I_WIN, I_RELB, I_QNORM, I_WQUP, I_KVNORM, I_WKVUP, I_WOUT, I_FG, I_FU, I_FD, I_POOLW, I_POOLS, I_ROUTER, I_MG, I_MU, I_MD };

struct Frame {
    LAS unsigned char* lds; int tid, lane, wave, vcu, G; unsigned char* ws; const float* const* in; float* out;
};
__device__ __forceinline__ const float* modv(const Frame& F, int layer, int s, int part) { return (const float*)(F.ws + WS_MODV) + ((size_t)(layer * 2 + s) * 6 + part) * D; }

__device__ __forceinline__ float kmax_q(const float* tab, int q, int lane) {
    const float* t = tab + q * 130; float m = fmaxf(t[lane], t[64 + lane]); if (lane < 2) m = fmaxf(m, t[128 + lane]);
#pragma unroll
    for (int o = 1; o < 64; o <<= 1) m = fmaxf(m, __shfl_xor(m, o));
    return m;
}
__device__ __forceinline__ int gu_row(int n0) { return (n0 >> 7) * 256 + (n0 & 127); }
constexpr int MOE_WE = 168, MOE_W = 8 * MOE_WE;
__device__ __forceinline__ unsigned pack4i8(float a, float b, float c, float d) {
    const int ia = (int)__builtin_rintf(a), ib = (int)__builtin_rintf(b), ic = (int)__builtin_rintf(c), id = (int)__builtin_rintf(d);
    return (unsigned)(ia & 255) | ((unsigned)(ib & 255) << 8) | ((unsigned)(ic & 255) << 16) | ((unsigned)id << 24);
}
__device__ __forceinline__ void conv_i8_strip(Frame& F, const float* W, int ldw, int n0, unsigned char* out8, int orow0, float* wsc, int nvalid = 64, float cs = 1.f) {
    LAS float* part = (LAS float*)(F.lds + RING_OFF + 12288);
    const bool live = F.lane < nvalid;
    const float* src = W + (size_t)(128 * F.wave) * ldw + n0 + (live ? F.lane : 0);
    const float csl = live ? cs : 0.f;
    float v[128]; float cm = 0.f;
#pragma unroll
    for (int i = 0; i < 128; ++i) v[i] = src[(size_t)i * ldw] * csl;
#pragma unroll
    for (int i = 0; i < 128; ++i) cm = fmaxf(cm, fabsf(v[i]));
#pragma unroll
    for (int o = 1; o < 64; o <<= 1) cm = fmaxf(cm, __shfl_xor(cm, o));
    part[F.wave * 64 + F.lane] = cm;
    __syncthreads();
#pragma unroll
    for (int w = 0; w < 8; ++w) cm = fmaxf(cm, part[w * 64 + F.lane]);
    const float sc = cm > 0.f ? 127.f / cm : 0.f;
    if (F.wave == 0) wsc[orow0 + F.lane] = cm * (1.f / 127.f);
    unsigned char* dst = out8 + (size_t)(orow0 + F.lane) * 1024 + 128 * F.wave;
#pragma unroll
    for (int g = 0; g < 8; ++g) { u32x4 o;
        o.x = pack4i8(v[16 * g] * sc, v[16 * g + 1] * sc, v[16 * g + 2] * sc, v[16 * g + 3] * sc); o.y = pack4i8(v[16 * g + 4] * sc, v[16 * g + 5] * sc, v[16 * g + 6] * sc, v[16 * g + 7] * sc);
        o.z = pack4i8(v[16 * g + 8] * sc, v[16 * g + 9] * sc, v[16 * g + 10] * sc, v[16 * g + 11] * sc); o.w = pack4i8(v[16 * g + 12] * sc, v[16 * g + 13] * sc, v[16 * g + 14] * sc, v[16 * g + 15] * sc);
        *(u32x4*)(dst + 16 * g) = o; }
    __syncthreads();
}
template <bool FP8>
__device__ __forceinline__ void conv_strip(const float* W, int ldw, int k0, int n0, void* out, int ldt, int orow0, int ocol0, const float* ks, const float* ns, float cs, int lane) {
    const float* src = W + (size_t)k0 * ldw + n0 + lane; const float nsv = (ns ? ns[n0 + lane] : 1.f) * cs;
    float v[128];
#pragma unroll
    for (int i = 0; i < 128; ++i) v[i] = src[(size_t)i * ldw] * nsv;
    if (ks) {
#pragma unroll
        for (int i = 0; i < 128; ++i) v[i] *= ks[k0 + i]; }
    if constexpr (FP8) { unsigned char* dst = (unsigned char*)out + (size_t)(orow0 + lane) * ldt + ocol0 + k0;
#pragma unroll
        for (int g = 0; g < 8; ++g) { int w[4];
#pragma unroll
            for (int q = 0; q < 4; ++q) { int t = 0; t = __builtin_amdgcn_cvt_pk_fp8_f32(v[16 * g + 4 * q], v[16 * g + 4 * q + 1], t, false); t = __builtin_amdgcn_cvt_pk_fp8_f32(v[16 * g + 4 * q + 2], v[16 * g + 4 * q + 3], t, true); w[q] = t; }
            *(u32x4*)(dst + 16 * g) = (u32x4){(unsigned)w[0], (unsigned)w[1], (unsigned)w[2], (unsigned)w[3]}; }
    } else { bf16* dst = (bf16*)out + (size_t)(orow0 + lane) * ldt + ocol0 + k0;
#pragma unroll
        for (int g = 0; g < 16; ++g) *(u32x4*)(dst + 8 * g) = (u32x4){cvtpk(v[8 * g], v[8 * g + 1]), cvtpk(v[8 * g + 2], v[8 * g + 3]), cvtpk(v[8 * g + 4], v[8 * g + 5]), cvtpk(v[8 * g + 6], v[8 * g + 7])}; }
}
constexpr int D_WQU = 24, D_WKV = 16, D_WOUT = 128, D_WDN = 352, D_POOL = 32, D_ALL = D_WQU + D_WKV + D_WOUT + D_WDN + D_POOL;
__device__ __forceinline__ void conv_dense_item(Frame& F, int j, int r) {
    if (r < D_WQU) { const int sb = r / 2, kb = r % 2; conv_strip<false>(F.in[I_WQUP] + (size_t)j * 256 * 768, 768, 128 * kb, 64 * sb, F.ws + WS_WUP + (size_t)j * 3 * MiB / 2, UP_K, 64 * sb, 0, F.in[I_QNORM] + j * 256, nullptr, QS_MLA, F.lane); return; } r -= D_WQU;
    if (r < D_WKV) { conv_strip<false>(F.in[I_WKVUP] + (size_t)j * 128 * 1024, 1024, 0, 64 * r, F.ws + WS_WUP + (size_t)j * 3 * MiB / 2, UP_K, 768 + 64 * r, 256, F.in[I_KVNORM] + j * 128, nullptr, 1.f, F.lane); return; } r -= D_WKV;
    if (r < D_WOUT) { const int sb = r / 8, kb = r % 8; conv_strip<false>(F.in[I_WOUT] + (size_t)j * D * D, D, 128 * kb, 64 * sb, F.ws + WS_WOUT + (size_t)j * D * D * 2, D, 64 * sb, 0, nullptr, nullptr, 1.f, F.lane); return; } r -= D_WOUT;
    if (r < D_WDN) { const int sb = r / 22, kb = r % 22; conv_strip<true>(F.in[I_FD] + (size_t)j * FFN * D, D, 128 * kb, 64 * sb, F.ws + WS_WDN + (size_t)j * 11 * MiB / 2, FFN, 64 * sb, 0, nullptr, nullptr, W8_SCALE, F.lane); return; } r -= D_WDN;
    { const int g = r / 8, q = r % 8, sb = q / 2, kb = q % 2; conv_strip<false>(F.in[I_POOLW] + (size_t)(j * 4 + g) * 65536, 256, 128 * kb, 64 * sb, F.ws + WS_WPOOL + (size_t)(j * 4 + g) * 65536 * 2, 256, 64 * sb, 0, nullptr, F.in[I_POOLS] + j * D + g * 256, 1.f, F.lane); }
}
__device__ __forceinline__ void conv_moedown_item(Frame& F, int j, int e, int q) {
    const int sb = q / 28, kb = q % 28;
    conv_strip<true>(F.in[I_MD] + (size_t)(j * 8 + e) * EDIM * D, D, 128 * kb, 64 * sb, F.ws + WS_MDN + (size_t)(j * 8 + e) * 7 * MiB, EDIM, 64 * sb, 0, nullptr, nullptr, W8_SCALE, F.lane);
}
__device__ __forceinline__ void moe_work(Frame& F, int j, int w) {
    const int e = w / MOE_WE, r = w % MOE_WE;
    if (r < 112) { const int up = r / 56, n0 = 64 * (r % 56);
        conv_i8_strip(F, F.in[up ? I_MU : I_MG] + (size_t)(j * 8 + e) * D * EDIM, EDIM, n0, F.ws + WS_MGU + (size_t)(j * 8 + e) * 7 * MiB, gu_row(n0) + up * 128, (float*)(F.ws + WS_WSCM) + (size_t)(j * 8 + e) * 7168);
    } else { const int c = r - 112; conv_moedown_item(F, j, e, c * 8 + F.wave); }
}
__device__ __forceinline__ void p0_prologue(Frame& F0) {
    Frame F = F0; { int t = threadIdx.x; asm volatile("" : "+v"(t)); F.tid = t; F.lane = t & 63; F.wave = __builtin_amdgcn_readfirstlane(t >> 6); }
    LAS float* scr = (LAS float*)(F.lds + RING_OFF + F.wave * 16384);
    const int gw = F.vcu * NWAVES + F.wave, NGW = F.G * NWAVES;
    {
        LAS float* sl = (LAS float*)(F.lds + 65536);
        LAS float* part = (LAS float*)(F.lds + 65536 + 8192);
        for (int it = blockIdx.x; it < 4 * 48; it += F.G) {
            const int layer = it / 48, ch = it % 48;
            for (int k = F.tid; k < 2048; k += NTHREADS) { const float v = (k < 1024) ? F.in[I_C][k] : F.in[I_CCTX][k - 1024]; sl[k] = v / (1.f + __expf(-v)); }
            __syncthreads();
            const float* W = F.in[I_MODW] + (size_t)layer * D * 6 * D + ch * 128 + 2 * F.lane;
            float a0 = 0.f, a1 = 0.f, b0 = 0.f, b1 = 0.f;
#pragma unroll 8
            for (int kk = 0; kk < 128; ++kk) { const int k = F.wave * 128 + kk; const f32x2 w = *(const f32x2*)(W + (size_t)k * 6 * D); const float sa = sl[k], sb = sl[1024 + k];
                a0 += sa * w[0]; a1 += sa * w[1]; b0 += sb * w[0]; b1 += sb * w[1]; }
            part[(F.wave * 2 + 0) * 128 + 2 * F.lane] = a0; part[(F.wave * 2 + 0) * 128 + 2 * F.lane + 1] = a1;
            part[(F.wave * 2 + 1) * 128 + 2 * F.lane] = b0; part[(F.wave * 2 + 1) * 128 + 2 * F.lane + 1] = b1;
            __syncthreads();
            if (F.tid < 256) { const int s = F.tid >> 7, cidx = F.tid & 127; float v = F.in[I_MODB][(size_t)layer * 6 * D + ch * 128 + cidx];
#pragma unroll
                for (int w = 0; w < 8; ++w) v += part[(w * 2 + s) * 128 + cidx];
                ((float*)(F.ws + WS_MODV))[(size_t)(layer * 2 + s) * 6 * D + ch * 128 + cidx] = v; }
            __syncthreads();
        }
    }
    if (blockIdx.x == F.G - 1) for (int i = F.tid; i < 2048; i += NTHREADS) { const int pos = i >> 3, f = i & 7; const double inv = exp(-log(10000.0) * (double)f / 8.0), ang = (double)pos * inv;
        float* t = (float*)(F.ws + WS_ROPE) + pos * 16; t[f] = (float)cos(ang); t[8 + f] = (float)sin(ang); }
    {
        const int gt = F.vcu * NTHREADS + F.tid, NGT = F.G * NTHREADS; const u32x4 z = {0u, 0u, 0u, 0u};
        constexpr int NZ_WIN = 64 * 64, NZ_A = 768 * 16, NZ_B = 1024 * 32, NZ = NZ_WIN + NZ_A + NZ_B;
        for (int i = gt; i < 2 * NZ; i += NGT) { const int j = i / NZ; int r = i % NZ;
            unsigned char* win = F.ws + WS_WIN + (size_t)j * 2048 * 1024; bf16* wup = (bf16*)(F.ws + WS_WUP + (size_t)j * 3 * MiB / 2);
            if (r < NZ_WIN) { *(u32x4*)(win + (size_t)(1984 + r / 64) * 1024 + (r % 64) * 16) = z; if (r < 64) ((float*)(F.ws + WS_WSCI))[j * 2048 + 1984 + r] = 0.f; continue; } r -= NZ_WIN;
            if (r < NZ_A) { *(u32x4*)(wup + (size_t)(r / 16) * UP_K + 256 + (r % 16) * 8) = z; continue; } r -= NZ_A;
            *(u32x4*)(wup + (size_t)(768 + r / 32) * UP_K + (r % 32) * 8) = z; }
    }
    { const int n0w = MOE_W, n1w = MOE_W;
      for (int it = blockIdx.x; it < 62; it += F.G) { const int j = it / 31, n0 = 64 * (it % 31);
          conv_i8_strip(F, F.in[I_WIN] + (size_t)j * D * IN_COLS, IN_COLS, n0, F.ws + WS_WIN + (size_t)j * 2048 * 1024, n0, (float*)(F.ws + WS_WSCI) + j * 2048, n0 + 64 <= IN_COLS ? 64 : IN_COLS - n0, n0 < 512 ? QS_NA : 1.f); }
      for (int it = blockIdx.x; it < 176 + n0w + n1w; it += F.G) {
        if (it < 176) { const int j = it / 88, q = it % 88, up = q / 44, n0 = 64 * (q % 44);
            conv_i8_strip(F, F.in[up ? I_FU : I_FG] + (size_t)j * D * FFN, FFN, n0, F.ws + WS_WGU + (size_t)j * 5632 * 1024, gu_row(n0) + up * 128, (float*)(F.ws + WS_WSC) + j * 5632); }
        else if (it - 176 < n0w) moe_work(F, 0, (MOE_W - n0w) + (it - 176));
        else moe_work(F, 1, (MOE_W - n1w) + (it - 176 - n0w)); } }
    for (int it = gw; it < 2 * D_ALL; it += NGW) conv_dense_item(F, it / D_ALL, it % D_ALL);
}

__device__ __forceinline__ void ld16(const float* p, int lane, float (&v)[16]) {
#pragma unroll
    for (int j = 0; j < 4; ++j) { const f32x4 t = *(const f32x4*)(p + 256 * j + 4 * lane); v[4 * j] = t[0]; v[4 * j + 1] = t[1]; v[4 * j + 2] = t[2]; v[4 * j + 3] = t[3]; }
}
__device__ __forceinline__ void st16(float* p, int lane, const float (&v)[16]) {
#pragma unroll
    for (int j = 0; j < 4; ++j) *(f32x4*)(p + 256 * j + 4 * lane) = (f32x4){v[4 * j], v[4 * j + 1], v[4 * j + 2], v[4 * j + 3]};
}
__device__ __forceinline__ void st16bf(bf16* p, int lane, const float (&v)[16]) {
#pragma unroll
    for (int j = 0; j < 4; ++j) *(u32x2*)(p + 256 * j + 4 * lane) = (u32x2){cvtpk(v[4 * j], v[4 * j + 1]), cvtpk(v[4 * j + 2], v[4 * j + 3])};
}
__device__ __forceinline__ void addbf16(const bf16* p, int lane, float (&v)[16]) {
#pragma unroll
    for (int j = 0; j < 4; ++j) { const u32x2 w = *(const u32x2*)(p + 256 * j + 4 * lane); v[4 * j] += bf_lo(w.x); v[4 * j + 1] += bf_hi(w.x); v[4 * j + 2] += bf_lo(w.y); v[4 * j + 3] += bf_hi(w.y); }
}
struct RowPass {
    const float* src_lat; const float* src_ctx;
    float* dst_lat; float* dst_ctx;
    bool do_ctx;
    bool skip_lat_store;
    const float* ln_g; const float* ln_b;
    const float* sh_lat; const float* sc_lat; const float* sh_ctx; const float* sc_ctx;
    bool write_h; bool h8; bool hi8; float* hsc; bf16* H;
    const float* g2_lat; const float* g2_ctx; const bf16* OUTm; const bf16* OUTm2; const int* rowslot; const unsigned* cnt;
    const float* router; int* rowslot_w; int* listTok; float* listW; unsigned* cnt_w;
};
template <bool DO_LN, bool MOE_IN, bool ROUTE>
__device__ __forceinline__ void row_pass(Frame& F0, const RowPass& P) {
    Frame F = F0; { int t = threadIdx.x; asm volatile("" : "+v"(t)); F.tid = t; F.lane = t & 63; F.wave = __builtin_amdgcn_readfirstlane(t >> 6); }
    LAS float* rt = (LAS float*)(F.lds);
    LAS int* selE = (LAS int*)(F.lds + 32768);
    LAS float* selW = (LAS float*)(F.lds + 32768 + 1024);
    LAS int* selR = (LAS int*)(F.lds + 32768 + 2048);
    int nsel = 0;
    if (ROUTE) { for (int i = F.tid; i < 8192; i += NTHREADS) rt[(i & 7) * 1024 + (i >> 3)] = P.router[i]; __syncthreads(); }
    int pb[8];
    if (MOE_IN) { int p = 0;
#pragma unroll
        for (int e = 0; e < 8; ++e) { const int n = (int)__hip_atomic_load(P.cnt + 64 * e, __ATOMIC_RELAXED, __HIP_MEMORY_SCOPE_AGENT); pb[e] = p; p += (n + 255) >> 8; } }
    float lg[16], lb[16];
    if (DO_LN) { ld16(P.ln_g, F.lane, lg); ld16(P.ln_b, F.lane, lb); }
    for (int s = P.do_ctx ? 0 : 1; s < 2; ++s) {
        const int n = s ? NLAT : NCTX, per = (n + F.G - 1) / F.G, r_lo = F.vcu * per, r_hi = min(r_lo + per, n);
        const float* src = s ? P.src_lat : P.src_ctx; float* dst = s ? P.dst_lat : P.dst_ctx;
        float sh[16], sc[16], g2[16];
        if (P.write_h) { ld16(s ? P.sh_lat : P.sh_ctx, F.lane, sh); ld16(s ? P.sc_lat : P.sc_ctx, F.lane, sc); }
        if (MOE_IN) ld16(s ? P.g2_lat : P.g2_ctx, F.lane, g2);
        for (int r = r_lo + F.wave; r < r_hi; r += NWAVES) {
            const int grow = s ? NCTX + r : r;
            float v[16]; ld16(src + (size_t)r * D, F.lane, v);
            if (MOE_IN) {
                const int e1 = P.rowslot[grow * 4 + 0], p1 = P.rowslot[grow * 4 + 1], e2 = P.rowslot[grow * 4 + 2], p2 = P.rowslot[grow * 4 + 3];
                int b1 = 0, b2 = 0;
#pragma unroll
                for (int e = 0; e < 8; ++e) { if (e1 == e) b1 = pb[e]; if (e2 == e) b2 = pb[e]; }
                float y[16];
#pragma unroll
                for (int i = 0; i < 16; ++i) y[i] = 0.f;
                addbf16(P.OUTm + (size_t)(b1 * 256 + p1) * D, F.lane, y); addbf16(P.OUTm + (size_t)(b2 * 256 + p2) * D, F.lane, y);
                addbf16(P.OUTm2 + (size_t)(b1 * 256 + p1) * D, F.lane, y); addbf16(P.OUTm2 + (size_t)(b2 * 256 + p2) * D, F.lane, y);
#pragma unroll
                for (int i = 0; i < 16; ++i) v[i] = v[i] * ALPHA + g2[i] * y[i];
            }
            if (DO_LN) {
                float sm = 0.f;
#pragma unroll
                for (int i = 0; i < 16; ++i) sm += v[i];
                const float mean = wave_sum(sm) * (1.f / D); float s2 = 0.f;
#pragma unroll
                for (int i = 0; i < 16; ++i) { v[i] -= mean; s2 += v[i] * v[i]; }
                const float rstd = rsqrtf(wave_sum(s2) * (1.f / D) + LN_EPS);
#pragma unroll
                for (int i = 0; i < 16; ++i) v[i] = v[i] * rstd * lg[i] + lb[i];
            }
            if (!(P.skip_lat_store && s == 1)) st16(dst + (size_t)r * D, F.lane, v);
            if (P.write_h) {
#pragma unroll
                for (int i = 0; i < 16; ++i) v[i] = v[i] * (1.f + sc[i]) + sh[i];
                if (P.hi8) { float am = 0.f;
#pragma unroll
                    for (int i = 0; i < 16; ++i) am = fmaxf(am, fabsf(v[i]));
#pragma unroll
                    for (int o = 1; o < 64; o <<= 1) am = fmaxf(am, __shfl_xor(am, o));
                    const float qs = am > 0.f ? 127.f / am : 0.f;
                    if (F.lane == 0) P.hsc[grow] = am * (1.f / 127.f);
#pragma unroll
                    for (int jj = 0; jj < 4; ++jj) *(unsigned*)((unsigned char*)P.H + (size_t)grow * D + 256 * jj + 4 * F.lane) = pack4i8(v[4 * jj] * qs, v[4 * jj + 1] * qs, v[4 * jj + 2] * qs, v[4 * jj + 3] * qs);
                } else if (P.h8) {
#pragma unroll
                    for (int jj = 0; jj < 4; ++jj) { int w = 0; w = __builtin_amdgcn_cvt_pk_fp8_f32(v[4 * jj], v[4 * jj + 1], w, false); w = __builtin_amdgcn_cvt_pk_fp8_f32(v[4 * jj + 2], v[4 * jj + 3], w, true);
                        *(int*)((unsigned char*)P.H + (size_t)grow * D + 256 * jj + 4 * F.lane) = w; }
                } else st16bf(P.H + (size_t)grow * D, F.lane, v);
                if (ROUTE) {
                    float lgt[8];
#pragma unroll
                    for (int e = 0; e < 8; ++e) { float a = 0.f;
#pragma unroll
                        for (int j = 0; j < 4; ++j) { const f32x4 w = *(const LAS f32x4*)(rt + e * 1024 + 256 * j + 4 * F.lane); a += v[4 * j] * w[0] + v[4 * j + 1] * w[1] + v[4 * j + 2] * w[2] + v[4 * j + 3] * w[3]; }
                        lgt[e] = wave_sum(a); }
                    int e1 = 0; float v1 = lgt[0];
#pragma unroll
                    for (int e = 1; e < 8; ++e) if (lgt[e] > v1) { v1 = lgt[e]; e1 = e; }
                    int e2 = -1; float v2 = -INFINITY;
#pragma unroll
                    for (int e = 0; e < 8; ++e) if (e != e1 && lgt[e] > v2) { v2 = lgt[e]; e2 = e; }
                    const float w1 = 1.f / (1.f + __expf(v2 - v1)), w2 = 1.f - w1;
                    const int slot = F.wave + 8 * nsel; ++nsel;
                    if (F.lane == 0) { selE[slot * 2] = e1; selE[slot * 2 + 1] = e2; selW[slot * 2] = w1; selW[slot * 2 + 1] = w2; selR[slot] = grow; }
                }
            }
        }
    }
    if (ROUTE) {
        LAS int* nselL = (LAS int*)(F.lds + 32768 + 3072);
        if (F.lane == 0) nselL[F.wave] = nsel;
        __syncthreads();
        if (F.tid < 8) { const int e = F.tid; int c = 0;
            for (int w = 0; w < 8; ++w) for (int k = 0; k < nselL[w]; ++k) { const int sl = w + 8 * k; c += (selE[sl * 2] == e) + (selE[sl * 2 + 1] == e); }
            int base = (int)__hip_atomic_fetch_add(P.cnt_w + 64 * e, (unsigned)c, __ATOMIC_RELAXED, __HIP_MEMORY_SCOPE_AGENT);
            for (int w = 0; w < 8; ++w) for (int k = 0; k < nselL[w]; ++k) { const int sl = w + 8 * k; const int grow = selR[sl];
                if (selE[sl * 2] == e) { P.listTok[(size_t)e * NTOK + base] = grow; P.listW[(size_t)e * NTOK + base] = selW[sl * 2]; P.rowslot_w[grow * 4 + 0] = e; P.rowslot_w[grow * 4 + 1] = base; ++base; }
                if (selE[sl * 2 + 1] == e) { P.listTok[(size_t)e * NTOK + base] = grow; P.listW[(size_t)e * NTOK + base] = selW[sl * 2 + 1]; P.rowslot_w[grow * 4 + 2] = e; P.rowslot_w[grow * 4 + 3] = base; ++base; } }
        }
        __syncthreads();
    }
}

template <bool FP8>
__device__ __forceinline__ void ctx_gemm_resid(Frame& F0, const void* A_, int lda, int acs, const void* Bt_, int ldb, int K, float* Xc, const float* gate, float sc = 1.f) {
    Frame F = F0; { int t = threadIdx.x; asm volatile("" : "+v"(t)); F.tid = t; F.lane = t & 63; F.wave = __builtin_amdgcn_readfirstlane(t >> 6); }
    LAS float* red = (LAS float*)(F.lds + RING_OFF);
    const int r32 = F.lane & 31, hi = F.lane >> 5;
    for (int tile = F.vcu; tile < 256; tile += F.G) {
        const int rb = tile >> 5, cb = tile & 31, row0 = 32 * rb, col0 = 32 * cb;
        f32x16 acc = {};
        const int nsteps = K / 128;
        if constexpr (FP8) {
            const unsigned char* ap = (const unsigned char*)A_ + (size_t)(row0 + r32) * lda + ((col0 >> 8) * acs) + 8 * hi;
            const unsigned char* bp = (const unsigned char*)Bt_ + (size_t)(col0 + r32) * ldb + 8 * hi;
#pragma unroll 2
            for (int i = 0; i < nsteps; i += 2) { const int k0 = (F.wave * nsteps + i) * 16;
                const long a0 = *(const long*)(ap + k0), b0 = *(const long*)(bp + k0), a1 = *(const long*)(ap + k0 + 16), b1 = *(const long*)(bp + k0 + 16);
                acc = __builtin_amdgcn_mfma_f32_32x32x16_fp8_fp8(a0, b0, acc, 0, 0, 0); acc = __builtin_amdgcn_mfma_f32_32x32x16_fp8_fp8(a1, b1, acc, 0, 0, 0); }
        } else {
            const bf16* ap = (const bf16*)A_ + (size_t)(row0 + r32) * lda + ((col0 >> 8) * acs) + 8 * hi;
            const bf16* bp = (const bf16*)Bt_ + (size_t)(col0 + r32) * ldb + 8 * hi;
#pragma unroll 2
            for (int i = 0; i < nsteps; i += 2) { const int k0 = (F.wave * nsteps + i) * 16;
                const bf16x8 a0 = *(const bf16x8*)(ap + k0), b0 = *(const bf16x8*)(bp + k0), a1 = *(const bf16x8*)(ap + k0 + 16), b1 = *(const bf16x8*)(bp + k0 + 16);
                acc = __builtin_amdgcn_mfma_f32_32x32x16_bf16(a0, b0, acc, 0, 0, 0); acc = __builtin_amdgcn_mfma_f32_32x32x16_bf16(a1, b1, acc, 0, 0, 0); }
        }
#pragma unroll
        for (int r = 0; r < 16; ++r) red[(F.wave * 16 + r) * 64 + F.lane] = acc[r];
        __syncthreads();
#pragma unroll
        for (int q = 0; q < 2; ++q) { const int o = F.tid + 512 * q, m = o >> 5, n = o & 31;
            const int h = (m >> 2) & 1, rg = (m & 3) + 4 * (m >> 3); float sum = 0.f;
#pragma unroll
            for (int w = 0; w < 8; ++w) sum += red[(w * 16 + rg) * 64 + n + 32 * h];
            float* xp = Xc + (size_t)(row0 + m) * D + col0 + n; *xp = *xp * ALPHA + gate[col0 + n] * (sum * sc); }
        __syncthreads();
    }
}
__device__ __forceinline__ void pool_pass(Frame& F0, const float* Xl, const float* Xc, bool do_ctx, const float* sc_lat, const float* sc_ctx, bf16* PM) {
    Frame F = F0; { int t = threadIdx.x; asm volatile("" : "+v"(t)); F.tid = t; F.lane = t & 63; F.wave = __builtin_amdgcn_readfirstlane(t >> 6); }
    const int hw = F.vcu * 2 + (F.tid >> 8), NHW = F.G * 2, c4 = (F.tid & 255) * 4, half = 1 << (c4 >> 8);
    const int nstrips = 512 + (do_ctx ? 32 : 0);
    for (int st = hw; st < nstrips; st += NHW) {
        const bool isl = st < 512; const int n = isl ? NLAT : NCTX, t0 = isl ? st * 32 : (st - 512) * 8, t1 = t0 + (isl ? 32 : 8);
        const float* X = (isl ? Xl : Xc) + c4; bf16* out = PM + (size_t)(isl ? NCTX : 0) * D + c4;
        const f32x4 scv = *(const f32x4*)((isl ? sc_lat : sc_ctx) + c4) + 1.f;
        f32x4 S = {0.f, 0.f, 0.f, 0.f};
        for (int tt = max(0, t0 - half); tt < min(n, t0 + half); ++tt) S += *(const f32x4*)(X + (size_t)tt * D);
        for (int tb = t0; tb < t1; tb += 8) {
            f32x4 xa[8], xp[8], xm[8];
#pragma unroll
            for (int i = 0; i < 8; ++i) { const int t = tb + i;
                xa[i] = *(const f32x4*)(X + (size_t)t * D);
                xp[i] = *(const f32x4*)(X + (size_t)min(t + half, n - 1) * D) * ((t + half < n) ? 1.f : 0.f);
                xm[i] = *(const f32x4*)(X + (size_t)max(t - half, 0) * D) * ((t - half >= 0) ? 1.f : 0.f); }
#pragma unroll
            for (int i = 0; i < 8; ++i) { const int t = tb + i;
                const int lo = max(0, t - half), hi = min(n, t + half);
                const f32x4 m = (S * (1.f / (float)(hi - lo)) - xa[i]) * scv;
                *(u32x2*)(out + (size_t)t * D) = (u32x2){cvtpk(m[0], m[1]), cvtpk(m[2], m[3])};
                S += xp[i]; S -= xm[i]; }
        }
    }
}
__device__ __forceinline__ void gather_pass(Frame& F0, const unsigned* cnt, const int* listTok, const bf16* H, bf16* AP, const float* hsc, float* hscm) {
    Frame F = F0; { int t = threadIdx.x; asm volatile("" : "+v"(t)); F.tid = t; F.lane = t & 63; F.wave = __builtin_amdgcn_readfirstlane(t >> 6); }
    int ne[8], pb[8], p = 0;
#pragma unroll
    for (int e = 0; e < 8; ++e) { ne[e] = (int)__hip_atomic_load(cnt + 64 * e, __ATOMIC_RELAXED, __HIP_MEMORY_SCOPE_AGENT); pb[e] = p; p += (ne[e] + 255) >> 8; }
    const int total = p * 256, gw = F.vcu * NWAVES + F.wave, NGW = F.G * NWAVES;
    for (int s0 = gw * 4; s0 < total; s0 += NGW * 4) {
        int tok[4];
#pragma unroll
        for (int i = 0; i < 4; ++i) { const int s = s0 + i; int es = 0, ps = 0, ns = 0;
#pragma unroll
            for (int e = 0; e < 8; ++e) if (s >= pb[e] * 256) { es = e; ps = s - pb[e] * 256; ns = ne[e]; }
            tok[i] = (ps < ns) ? listTok[(size_t)es * NTOK + ps] : -1; }
        u32x4 a[4]; float hs[4];
#pragma unroll
        for (int i = 0; i < 4; ++i) { const int tk = max(tok[i], 0); a[i] = ((const u32x4*)((const unsigned char*)H + (size_t)tk * D))[F.lane]; hs[i] = hsc[tk]; }
#pragma unroll
        for (int i = 0; i < 4; ++i) { const bool v = tok[i] >= 0; const u32x4 z = {0u, 0u, 0u, 0u};
            ((u32x4*)((unsigned char*)AP + (size_t)(s0 + i) * D))[F.lane] = v ? a[i] : z; if (F.lane == 0) hscm[s0 + i] = v ? hs[i] : 0.f; }
    }
}

constexpr int PH_PRO = 0, PH_INIT = 1, PH_BASE = 2, PH_PER_J = 15, PH_TOTAL = PH_BASE + 2 * PH_PER_J;

__global__ void __launch_bounds__(NTHREADS, 2) trunk_fwd(Args args) {
    extern __shared__ __attribute__((aligned(16))) unsigned char lds[];
    Frame F;
    F.lds = (LAS unsigned char*)lds; F.tid = threadIdx.x; F.lane = F.tid & 63; F.wave = __builtin_amdgcn_readfirstlane(F.tid >> 6);
    F.G = gridDim.x; { const int bx = blockIdx.x; F.vcu = (F.G % 8 == 0) ? (bx % 8) * (F.G / 8) + bx / 8 : bx; }
    F.ws = args.ws; F.in = args.in; F.out = args.out;
    unsigned* ctl = (unsigned*)(F.ws + WS_CTL);
    for (int u = F.tid; u < (LDS_BYTES - LDSCTL_OFF) / 4; u += NTHREADS) ((LAS unsigned*)(F.lds + LDSCTL_OFF))[u] = 0u;
    __syncthreads();
    const int lo = args.ph_lo, hi = args.ph_hi;
    const bool multi = (hi - lo) > 1;
    XcdBarrier bar; bar.bar = ctl + CW_BAR; bar.x = 0; bar.st = nullptr;
    if (multi) bar = xcd_barrier_post(ctl + CW_BAR, (volatile LAS unsigned*)(F.lds + MISC_OFF) + 8);
#define IN(k) (lo <= (k) && (k) < hi)
#define SEAM(k) do { if (IN(k) && IN((k) + 1)) xcd_barrier(bar); } while (0)
#define W_ring (F.lds + RING_OFF)
#define W_Xl (F.out)
#define W_Xc ((float*)(F.ws + WS_XC))
#define W_H ((bf16*)(F.ws + WS_H))
#define W_OB ((bf16*)(F.ws + WS_OB))
#define W_PROJ ((bf16*)(F.ws + WS_PROJ))
#define W_QM ((bf16*)(F.ws + WS_QM))
#define W_KM ((bf16*)(F.ws + WS_KM))
#define W_VM ((bf16*)(F.ws + WS_VM))
#define W_HID ((bf16*)(F.ws + WS_HID))
#define W_HIDM ((bf16*)(F.ws + WS_HIDM))
#define W_AP ((bf16*)(F.ws + WS_APERM))
#define W_SSQ ((float*)(F.ws + WS_SSQ))
#define W_rope ((const float*)(F.ws + WS_ROPE))
#define W_rowslot ((int*)(F.ws + WS_ROWSLOT))
#define W_listTok ((int*)(F.ws + WS_LISTTOK))
#define W_listW ((float*)(F.ws + WS_LISTW))

    if (EN(0) && IN(PH_PRO)) { p0_prologue(F); } SEAM(PH_PRO);
    if (EN(1) && IN(PH_INIT)) {
        RowPass P{}; P.src_lat = F.in[I_X]; P.src_ctx = F.in[I_CTX]; P.dst_lat = W_Xl; P.dst_ctx = W_Xc; P.do_ctx = true; P.skip_lat_store = true;
        P.sh_lat = modv(F, 0, 0, 0); P.sc_lat = modv(F, 0, 0, 1); P.sh_ctx = modv(F, 0, 1, 0); P.sc_ctx = modv(F, 0, 1, 1); P.write_h = true; P.hi8 = true; P.hsc = (float*)(F.ws + WS_HSC); P.H = W_H;
        row_pass<false, false, false>(F, P);
    } SEAM(PH_INIT);

    for (int j = 0; j < 2; ++j) {
        const int pe = PH_BASE + j * PH_PER_J, le = 2 * j, lod = 2 * j + 1;
        const bool ctx_e = (j == 0);
        const bool ctx_o = (j == 0);
        if (EN(2) && IN(pe + 0)) {
            pg8::DenseOrder S; S.init(65, 8, 0, F.G, (int)blockIdx.x, W_H, (size_t)256 * D, 0, F.ws + WS_WIN + (size_t)j * 2048 * 1024, (size_t)256 * 1024);
            pg8::EpiProj E{W_PROJ, W_SSQ, W_KM, W_rope, (float*)(F.ws + WS_KMAXP) + j * 33 * 130, (const float*)(F.ws + WS_HSC), (const float*)(F.ws + WS_WSCI) + j * 2048};
            pg8::gemm_phase<pg8::EpiProj, pg8::DenseOrder, 2>(W_ring, 512, 512, 512, S, E);
        } SEAM(pe + 0);
        if (EN(3) && IN(pe + 1)) {
            pg8::DenseOrder S; S.init(65, 7, 0, F.G, (int)blockIdx.x, W_PROJ + 1536, (size_t)256 * PROJ_LD * 2, 0, (const bf16*)(F.ws + WS_WUP + (size_t)j * 3 * MiB / 2), (size_t)256 * UP_K * 2);
            pg8::EpiUp E{W_SSQ, W_QM, W_KM, W_VM, W_rope, (float*)(F.ws + WS_KMAXP) + j * 33 * 130};
            pg8::gemm_phase(W_ring, UP_K, PROJ_LD, UP_K, S, E);
        } SEAM(pe + 1);
        if (EN(4) && IN(pe + 2)) {
            const int U = 1024 + (ctx_e ? 16 : 0);
            const float* relb = F.in[I_RELB] + (size_t)j * 8 * 465;
            for (int id = F.vcu; id < U; id += F.G) {
                const bool isctx = id >= 1024; const int x = id - 1024;
                const bool mla = isctx ? (x < 8) : (id < 512);
                const int id2 = id & 511, rem = id2 & 255;
                const int head = isctx ? (x & 7) : (rem >> 5), qb = (rem & 31) + 32 * (id2 >> 8);
                const size_t qrow = isctx ? 0 : (size_t)(NCTX + qb * 256);
                if (mla) {
                    const float* km = (const float*)(F.ws + WS_KMAXP) + j * 33 * 130;
                    const float k2 = kmax_q(km, 0, F.lane) + kmax_q(km, 1 + head * 2, F.lane) + kmax_q(km, 2 + head * 2, F.lane);
                    mla::attn_unit<96, false, QM_LD, KM_LD, VM_LD, D>(W_QM + qrow * QM_LD + head * 96, W_KM + head * 96, W_VM + head * 64, W_OB + qrow * D + 512 + head * 64, isctx ? 4 : NTOK / 64, k2, 0, 0, nullptr, (LAS char*)W_ring);
                } else {
                    const int R0 = 4 * qb, krs = min(min(max(R0 - 4, 0), 248), 244);
                    const bf16* Ph = W_PROJ + head * 64;
                    const float* km = (const float*)(F.ws + WS_KMAXP) + j * 33 * 130;
                    const float k2 = kmax_q(km, 17 + head * 2, F.lane) + kmax_q(km, 18 + head * 2, F.lane);
                    mla::attn_unit<64, true, PROJ_LD, PROJ_LD, PROJ_LD, D>(Ph + qrow * PROJ_LD, Ph + 512, Ph + 1024, W_OB + qrow * D + head * 64, isctx ? 4 : 16, k2, krs, R0, relb + head * 465, (LAS char*)W_ring);
                }
            }
        } SEAM(pe + 2);
        if (EN(5) && IN(pe + 3)) {
            pg8::DenseOrder S; S.init(64, 4, 1, F.G, (int)blockIdx.x, W_OB, (size_t)256 * D * 2, 0, (const bf16*)(F.ws + WS_WOUT) + (size_t)j * D * D, (size_t)256 * D * 2);
            pg8::EpiResid E{W_Xl, W_Xc, modv(F, le, 0, 2), modv(F, le, 1, 2), j == 0 ? F.in[I_X] : (const float*)W_Xl};
            pg8::gemm_phase(W_ring, 1024, 1024, 1024, S, E);
            if (ctx_e) ctx_gemm_resid<false>(F, W_OB, D, 0, (const bf16*)(F.ws + WS_WOUT) + (size_t)j * D * D, D, 1024, W_Xc, modv(F, le, 1, 2));
        } SEAM(pe + 3);
        if (EN(6) && IN(pe + 4)) {
            RowPass P{}; P.src_lat = W_Xl; P.src_ctx = W_Xc; P.dst_lat = W_Xl; P.dst_ctx = W_Xc; P.do_ctx = ctx_e; P.ln_g = F.in[I_LN1G] + le * D; P.ln_b = F.in[I_LN1B] + le * D;
            P.sh_lat = modv(F, le, 0, 3); P.sc_lat = modv(F, le, 0, 4); P.sh_ctx = modv(F, le, 1, 3); P.sc_ctx = modv(F, le, 1, 4); P.write_h = true; P.hi8 = true; P.hsc = (float*)(F.ws + WS_HSC); P.H = W_H;
            row_pass<true, false, false>(F, P);
        } SEAM(pe + 4);
        if (EN(7) && IN(pe + 5)) {
            pg8::DenseOrder S; S.init(ctx_e ? 65 : 64, 22, ctx_e ? 0 : 1, F.G, (int)blockIdx.x, W_H, (size_t)256 * D, 0, F.ws + WS_WGU + (size_t)j * 5632 * 1024, (size_t)256 * 1024);
            pg8::EpiSwigluI8 E{W_HID, FFN, (const float*)(F.ws + WS_HSC), (const float*)(F.ws + WS_WSC) + j * 5632, 0, true};
            pg8::gemm_phase<pg8::EpiSwigluI8, pg8::DenseOrder, 2>(W_ring, 512, 512, 512, S, E);
        } SEAM(pe + 5);
        if (EN(8) && IN(pe + 6)) {
            pg8::DenseOrder S; S.init(64, 4, 1, F.G, (int)blockIdx.x, W_HID, (size_t)256 * FFN, 0, F.ws + WS_WDN + (size_t)j * 11 * MiB / 2, (size_t)256 * FFN);
            pg8::EpiResid E{W_Xl, W_Xc, modv(F, le, 0, 5), modv(F, le, 1, 5), W_Xl, W8_INV};
            pg8::gemm_phase<pg8::EpiResid, pg8::DenseOrder, 1>(W_ring, FFN / 2, FFN / 2, FFN / 2, S, E);
            if (ctx_e) ctx_gemm_resid<true>(F, W_HID, FFN, 0, F.ws + WS_WDN + (size_t)j * 11 * MiB / 2, FFN, FFN, W_Xc, modv(F, le, 1, 5), W8_INV);
        } SEAM(pe + 6);
        if (EN(9) && IN(pe + 7)) {
            RowPass P{}; P.src_lat = W_Xl; P.src_ctx = W_Xc; P.dst_lat = W_Xl; P.dst_ctx = W_Xc; P.do_ctx = ctx_e; P.ln_g = F.in[I_LN2G] + le * D; P.ln_b = F.in[I_LN2B] + le * D; P.write_h = false;
            row_pass<true, false, false>(F, P);
        } SEAM(pe + 7);
        if (EN(10) && IN(pe + 8)) { pool_pass(F, W_Xl, W_Xc, ctx_o, modv(F, lod, 0, 1), modv(F, lod, 1, 1), W_OB); } SEAM(pe + 8);
        if (EN(11) && IN(pe + 9)) {
            pg8::DenseOrder S; S.init(64, 4, 1, F.G, (int)blockIdx.x, W_OB, (size_t)256 * D * 2, (size_t)256 * 2, (const bf16*)(F.ws + WS_WPOOL) + (size_t)j * 4 * 65536, (size_t)65536 * 2);
            pg8::EpiResid E{W_Xl, W_Xc, modv(F, lod, 0, 2), modv(F, lod, 1, 2), W_Xl};
            pg8::gemm_phase(W_ring, 256, 1024, 256, S, E);
            if (ctx_o) ctx_gemm_resid<false>(F, W_OB, D, 256, (const bf16*)(F.ws + WS_WPOOL) + (size_t)j * 4 * 65536, 256, 256, W_Xc, modv(F, lod, 1, 2));
        } SEAM(pe + 9);
        if (EN(12) && IN(pe + 10)) {
            RowPass P{}; P.src_lat = W_Xl; P.src_ctx = W_Xc; P.dst_lat = W_Xl; P.dst_ctx = W_Xc; P.do_ctx = ctx_o; P.ln_g = F.in[I_LN1G] + lod * D; P.ln_b = F.in[I_LN1B] + lod * D;
            P.sh_lat = modv(F, lod, 0, 3); P.sc_lat = modv(F, lod, 0, 4); P.sh_ctx = modv(F, lod, 1, 3); P.sc_ctx = modv(F, lod, 1, 4); P.write_h = true; P.hi8 = true; P.hsc = (float*)(F.ws + WS_HSC); P.H = W_H;
            P.router = F.in[I_ROUTER] + (size_t)j * D * 8; P.rowslot_w = W_rowslot; P.listTok = W_listTok; P.listW = W_listW; P.cnt_w = ctl + CW_CNT + j * 8 * 64;
            row_pass<true, false, true>(F, P);
        } SEAM(pe + 10);
        if (EN(13) && IN(pe + 11)) { gather_pass(F, ctl + CW_CNT + j * 8 * 64, W_listTok, W_H, W_AP, (const float*)(F.ws + WS_HSC), (float*)(F.ws + WS_HSCM)); } SEAM(pe + 11);
        if (EN(14) && IN(pe + 12)) {
            pg8::MoeOrder S; S.init(ctl + CW_CNT + j * 8 * 64, 28, F.G, F.vcu, W_AP, (size_t)256 * D, F.ws + WS_MGU + (size_t)j * 8 * 7 * MiB, (size_t)7 * MiB, (size_t)256 * 1024, 28, 0);
            pg8::EpiSwigluI8 E{W_HIDM, EDIM, (const float*)(F.ws + WS_HSCM), (const float*)(F.ws + WS_WSCM) + (size_t)j * 8 * 7168, 7168, true};
            pg8::gemm_phase<pg8::EpiSwigluI8, pg8::MoeOrder, 2>(W_ring, 512, 512, 512, S, E);
        } SEAM(pe + 12);
        if (EN(15) && IN(pe + 13)) {
            pg8::MoeOrder S; S.init(ctl + CW_CNT + j * 8 * 64, 8, F.G, F.vcu, W_HIDM, (size_t)256 * EDIM, F.ws + WS_MDN + (size_t)j * 8 * 7 * MiB, (size_t)7 * MiB, (size_t)256 * EDIM, 4, (size_t)(EDIM / 2));
            pg8::EpiMoeDown E{W_AP, (bf16*)(F.ws + WS_OUT2), W_listW, W8_INV};
            pg8::gemm_phase<pg8::EpiMoeDown, pg8::MoeOrder, 1>(W_ring, EDIM / 4, EDIM / 2, EDIM / 2, S, E);
        } SEAM(pe + 13);
        if (EN(16) && IN(pe + 14)) {
            RowPass P{}; P.src_lat = W_Xl; P.src_ctx = W_Xc; P.dst_lat = W_Xl; P.dst_ctx = W_Xc; P.do_ctx = ctx_o; P.ln_g = F.in[I_LN2G] + lod * D; P.ln_b = F.in[I_LN2B] + lod * D;
            P.write_h = (j == 0); if (j == 0) { P.sh_lat = modv(F, 2, 0, 0); P.sc_lat = modv(F, 2, 0, 1); P.sh_ctx = modv(F, 2, 1, 0); P.sc_ctx = modv(F, 2, 1, 1); } P.hi8 = true; P.hsc = (float*)(F.ws + WS_HSC); P.H = W_H;
            P.g2_lat = modv(F, lod, 0, 5); P.g2_ctx = modv(F, lod, 1, 5); P.OUTm = W_AP; P.OUTm2 = (const bf16*)(F.ws + WS_OUT2); P.rowslot = W_rowslot; P.cnt = ctl + CW_CNT + j * 8 * 64;
            row_pass<true, true, false>(F, P);
        } SEAM(pe + 14);
    }
#if PROBE_PHASE == 40
    if (IN(40)) {
        for (int id = F.vcu; id < 512; id += F.G) { const int rem = id & 255, head = rem >> 5, qb = (rem & 31) + 32 * (id >> 8); const size_t qrow = (size_t)(NCTX + qb * 256);
            mla::attn_unit<96, false, QM_LD, KM_LD, VM_LD, D>(W_QM + qrow * QM_LD + head * 96, W_KM + head * 96, W_VM + head * 64, W_OB + qrow * D + 512 + head * 64, NTOK / 64, 200.f, 0, 0, nullptr, (LAS char*)W_ring); } }
#endif
#if PROBE_PHASE == 41
    if (IN(41)) {
        const float* relb = F.in[I_RELB] + (size_t)8 * 465;
        for (int id = F.vcu; id < 512; id += F.G) { const int rem = id & 255, head = rem >> 5, qb = (rem & 31) + 32 * (id >> 8); const size_t qrow = (size_t)(NCTX + qb * 256);
            const int R0 = 4 * qb, krs = min(min(max(R0 - 4, 0), 248), 244); const bf16* Ph = W_PROJ + head * 64;
            mla::attn_unit<64, true, PROJ_LD, PROJ_LD, PROJ_LD, D>(Ph + qrow * PROJ_LD, Ph + 512, Ph + 1024, W_OB + qrow * D + head * 64, 16, 150.f, krs, R0, relb + head * 465, (LAS char*)W_ring); } }
#endif
#if PROBE_PHASE == 42
    if (IN(42)) {
        RowPass P{}; P.src_lat = W_Xl; P.src_ctx = W_Xc; P.dst_lat = (float*)(F.ws + WS_HIDM); P.dst_ctx = (float*)(F.ws + WS_HIDM) + (size_t)NLAT * D; P.do_ctx = true; P.ln_g = F.in[I_LN1G]; P.ln_b = F.in[I_LN1B];
        P.sh_lat = modv(F, 0, 0, 3); P.sc_lat = modv(F, 0, 0, 4); P.sh_ctx = modv(F, 0, 1, 3); P.sc_ctx = modv(F, 0, 1, 4); P.write_h = true; P.H = (bf16*)(F.ws + WS_HIDM + 80 * MiB);
        row_pass<true, false, false>(F, P); }
#endif
#if PROBE_PHASE == 43
    if (IN(43)) {
        RowPass P{}; P.src_lat = W_Xl; P.src_ctx = W_Xc; P.dst_lat = (float*)(F.ws + WS_HIDM); P.dst_ctx = (float*)(F.ws + WS_HIDM) + (size_t)NLAT * D; P.do_ctx = false; P.ln_g = F.in[I_LN2G]; P.ln_b = F.in[I_LN2B];
        P.write_h = false; P.g2_lat = modv(F, 3, 0, 5); P.g2_ctx = modv(F, 3, 1, 5); P.OUTm = W_AP; P.OUTm2 = (const bf16*)(F.ws + WS_OUT2); P.rowslot = W_rowslot; P.cnt = ctl + CW_CNT + 8 * 64;
        row_pass<true, true, false>(F, P); }
#endif
#if PROBE_PHASE == 45
    if (IN(45)) {
        RowPass P{}; P.src_lat = W_Xl; P.src_ctx = W_Xc; P.dst_lat = (float*)(F.ws + WS_HIDM); P.dst_ctx = (float*)(F.ws + WS_HIDM) + (size_t)NLAT * D; P.do_ctx = true; P.ln_g = F.in[I_LN1G]; P.ln_b = F.in[I_LN1B];
        P.sh_lat = modv(F, 1, 0, 3); P.sc_lat = modv(F, 1, 0, 4); P.sh_ctx = modv(F, 1, 1, 3); P.sc_ctx = modv(F, 1, 1, 4); P.write_h = true; P.h8 = true; P.H = (bf16*)(F.ws + WS_HIDM + 80 * MiB);
        P.router = F.in[I_ROUTER]; P.rowslot_w = (int*)(F.ws + WS_HIDM + 120 * MiB); P.listTok = (int*)(F.ws + WS_HIDM + 122 * MiB); P.listW = (float*)(F.ws + WS_HIDM + 124 * MiB); P.cnt_w = ctl + CW_CNT + 16 * 64;
        row_pass<true, false, true>(F, P); }
#endif
#if PROBE_PHASE == 46
    if (IN(46)) {
        pg8::DenseOrder S; S.init(64, 4, 1, F.G, (int)blockIdx.x, W_HID, (size_t)256 * FFN, 0, F.ws + WS_WDN, (size_t)256 * FFN);
        pg8::EpiResid E{(float*)(F.ws + WS_HIDM), (float*)(F.ws + WS_HIDM) + (size_t)NLAT * D, modv(F, 2, 0, 5), modv(F, 2, 1, 5), (const float*)(F.ws + WS_HIDM), W8_INV};
        pg8::gemm_phase<pg8::EpiResid, pg8::DenseOrder, 1>(W_ring, FFN / 2, FFN / 2, FFN / 2, S, E); }
#endif
#if PROBE_PHASE == 47
    if (IN(47)) {
        pg8::DenseOrder S; S.init(64, 4, 1, F.G, (int)blockIdx.x, W_OB, (size_t)256 * D * 2, 0, (const bf16*)(F.ws + WS_WOUT), (size_t)256 * D * 2);
        pg8::EpiResid E{(float*)(F.ws + WS_HIDM), (float*)(F.ws + WS_HIDM) + (size_t)NLAT * D, modv(F, 2, 0, 2), modv(F, 2, 1, 2), (const float*)(F.ws + WS_HIDM)};
        pg8::gemm_phase(W_ring, 1024, 1024, 1024, S, E); }
#endif
#if PROBE_PHASE == 48
    if (IN(48)) {
        pg8::DenseOrder S; S.init(64, 4, 1, F.G, (int)blockIdx.x, W_OB, (size_t)256 * D * 2, (size_t)256 * 2, (const bf16*)(F.ws + WS_WPOOL), (size_t)65536 * 2);
        pg8::EpiResid E{(float*)(F.ws + WS_HIDM), (float*)(F.ws + WS_HIDM) + (size_t)NLAT * D, modv(F, 3, 0, 2), modv(F, 3, 1, 2), (const float*)(F.ws + WS_HIDM)};
        pg8::gemm_phase(W_ring, 256, 1024, 256, S, E); }
#endif
#if PROBE_PHASE == 50
    _Pragma("clang loop unroll(disable)") for (int q = 50; q < 60; ++q) { SEAM(q); }
#endif
#if 0
#endif
#undef IN
#undef SEAM
}

extern "C" void kernel_launch(void* const* d_in, const int* in_sizes, int n_in, void* d_out, int out_size, void* d_ws, size_t ws_size, hipStream_t stream) {
    static int grid = 0;
    if (grid == 0) {
        if (n_in != 26 || out_size != NLAT * D || ws_size < WS_END) { fprintf(stderr, "kernel_launch: unexpected shapes: n_in %d out %d ws %zu (need %zu)\n", n_in, out_size, ws_size, (size_t)WS_END); grid = -1; return; }
        int dev = 0, cus = 0;
        if (hipGetDevice(&dev) != hipSuccess || hipDeviceGetAttribute(&cus, hipDeviceAttributeMultiprocessorCount, dev) != hipSuccess) { grid = -1; return; }
        if (hipFuncSetAttribute((const void*)trunk_fwd, hipFuncAttributeMaxDynamicSharedMemorySize, LDS_BYTES) != hipSuccess) { fprintf(stderr, "kernel_launch: hipFuncSetAttribute failed\n"); grid = -1; return; }
        (void)hipGetLastError();
        grid = cus;
    }
    if (grid < 0) return;
    if (hipMemsetAsync((char*)d_ws + WS_CTL, 0, CTL_ZERO_BYTES, stream) != hipSuccess) return;
    Args a{};
    for (int i = 0; i < 26; ++i) a.in[i] = (const float*)d_in[i];
    a.out = (float*)d_out; a.ws = (unsigned char*)d_ws;
#if ONE_LAUNCH
    a.ph_lo = 0; a.ph_hi = PH_TOTAL;
    hipLaunchKernelGGL(trunk_fwd, dim3(grid), dim3(NTHREADS), LDS_BYTES, stream, a);
    if (PROBE_PHASE >= 0) { (void)hipMemsetAsync((char*)d_ws + WS_CTL + CW_BAR * 4, 0, XCD_BAR_WORDS * 4, stream); a.ph_lo = PROBE_PHASE; a.ph_hi = PROBE_HI; hipLaunchKernelGGL(trunk_fwd, dim3(grid), dim3(NTHREADS), LDS_BYTES, stream, a); }
#else
    for (int p = 0; p < PH_TOTAL; ++p) { a.ph_lo = p; a.ph_hi = p + 1; hipLaunchKernelGGL(trunk_fwd, dim3(grid), dim3(NTHREADS), LDS_BYTES, stream, a); }
#endif
}
```

```cpp
#include <hip/hip_runtime.h>
#include <cstdio>
#include <cstdint>

#ifndef ONE_LAUNCH
#define ONE_LAUNCH 1
#endif
#ifndef PROBE_PHASE
#define PROBE_PHASE -1
#endif
#ifndef PROBE_HI
#define PROBE_HI (PROBE_PHASE + 1)
#endif
#ifndef PHASE_EN
#define PHASE_EN 0x1ffffu
#endif
#define EN(k) (((PHASE_EN) >> (k)) & 1u)

#define GAS __attribute__((address_space(1)))
#define LAS __attribute__((address_space(3)))
typedef unsigned short bf16;
typedef short bf16x8 __attribute__((ext_vector_type(8)));
typedef short s16x4 __attribute__((ext_vector_type(4)));
typedef float f32x2 __attribute__((ext_vector_type(2)));
typedef float f32x4 __attribute__((ext_vector_type(4)));
typedef float f32x16 __attribute__((ext_vector_type(16)));
typedef unsigned u32x2 __attribute__((ext_vector_type(2)));
typedef unsigned u32x4 __attribute__((ext_vector_type(4)));
typedef __bf16 bf16x2_t __attribute__((ext_vector_type(2)));

constexpr int D = 1024, NLAT = 16384, NCTX = 256, NTOK = NLAT + NCTX;
constexpr int GRID_W = 64;
constexpr int PROJ_LD = 2048, IN_COLS = 1952;
constexpr int QM_LD = 768, KM_LD = 768, VM_LD = 512;
constexpr int FFN = 2816, EDIM = 3584, NEXP = 8;
constexpr int UP_N = 1792, UP_K = 384;
constexpr float ALPHA = 1.681792830507429f;
constexpr float LOG2E = 1.4426950408889634f;
constexpr float QS_NA = 0.125f * LOG2E;
constexpr float QS_MLA = 0.10206207261596575f * LOG2E;
constexpr float LN_EPS = 1e-5f, RMS_EPS = 1e-6f;
constexpr int MAXPANELS = 138;
constexpr float W8_SCALE = 32.f, W8_INV = 1.f / 32.f;

constexpr size_t MiB = 1u << 20;
constexpr size_t WS_CTL = 0, CTL_ZERO_BYTES = 1 * MiB;
constexpr size_t WS_MODV = 1 * MiB;
constexpr size_t WS_ROPE = 1 * MiB + 256 * 1024;
constexpr size_t WS_WSCM = 1 * MiB + 512 * 1024;
constexpr size_t WS_XC = 2 * MiB;
constexpr size_t WS_SSQ = 3 * MiB;
constexpr size_t WS_HSCM = 4 * MiB + 512 * 1024;
constexpr size_t WS_KMAXP = 4 * MiB + 768 * 1024;
constexpr size_t WS_ROWSLOT = 5 * MiB;
constexpr size_t WS_LISTTOK = 6 * MiB;
constexpr size_t WS_LISTW = 7 * MiB;
constexpr size_t WS_WSC = 7 * MiB + 768 * 1024;
constexpr size_t WS_WSCI = 7 * MiB + 832 * 1024;
constexpr size_t WS_HSC = 7 * MiB + 896 * 1024;
constexpr size_t WS_WIN = 8 * MiB;
constexpr size_t WS_WUP = 16 * MiB;
constexpr size_t WS_WPOOL = 19 * MiB;
constexpr size_t WS_WOUT = 20 * MiB;
constexpr size_t WS_WGU = 24 * MiB;
constexpr size_t WS_WDN = 46 * MiB;
constexpr size_t WS_MGU = 58 * MiB;
constexpr size_t WS_MDN = 282 * MiB;
constexpr size_t WS_H = 394 * MiB;
constexpr size_t WS_OB = 427 * MiB;
constexpr size_t WS_PROJ = 460 * MiB;
constexpr size_t WS_QM = 525 * MiB;
constexpr size_t WS_KM = 550 * MiB;
constexpr size_t WS_VM = 575 * MiB;
constexpr size_t WS_HID = 592 * MiB;
constexpr size_t WS_HIDM = 460 * MiB;
constexpr size_t WS_APERM = 702 * MiB;
constexpr size_t WS_OUT2 = 772 * MiB;
constexpr size_t WS_END = 842 * MiB;
static_assert(WS_HID + (size_t)NTOK * FFN * 2 <= WS_APERM && WS_HIDM + (size_t)MAXPANELS * 256 * EDIM * 2 <= WS_APERM && WS_APERM + (size_t)MAXPANELS * 256 * D * 2 <= WS_OUT2 && WS_OUT2 + (size_t)MAXPANELS * 256 * D * 2 <= WS_END, "ws map");
static_assert(WS_MGU + 16 * 14 * MiB <= WS_MDN && WS_MDN + 16 * 7 * MiB <= WS_H && WS_H + (size_t)NTOK * D * 2 <= WS_OB && WS_OB + (size_t)NTOK * D * 2 <= WS_PROJ, "ws map 2");
static_assert(WS_PROJ + (size_t)NTOK * PROJ_LD * 2 <= WS_QM && WS_QM + (size_t)NTOK * QM_LD * 2 <= WS_KM && WS_KM + (size_t)NTOK * KM_LD * 2 <= WS_VM && WS_VM + (size_t)NTOK * VM_LD * 2 <= WS_HID, "ws map 3");
constexpr int CW_BAR = 4096;
constexpr int CW_CNT = 8192;
constexpr int CW_KMAX = 12288;

__device__ __forceinline__ unsigned cvtpk(float lo, float hi) { f32x2 v = {lo, hi}; bf16x2_t b = __builtin_convertvector(v, bf16x2_t); return __builtin_bit_cast(unsigned, b); }
__device__ __forceinline__ float bf_lo(unsigned w) { return __uint_as_float(w << 16); }
__device__ __forceinline__ float bf_hi(unsigned w) { return __uint_as_float(w & 0xffff0000u); }
__device__ __forceinline__ float wave_sum(float v) {
#pragma unroll
    for (int o = 1; o < 64; o <<= 1) v += __shfl_xor(v, o);
    return v;
}
#define LDS_WAIT() asm volatile("s_waitcnt lgkmcnt(0)" ::: "memory")
#define VM_WAIT() asm volatile("s_waitcnt vmcnt(0)" ::: "memory")

namespace pg8 {
constexpr int BM = 256, BK = 64, HALF = 128, HTB = HALF * BK * 2, STAGE_BYTES = 8 * HTB, NXCD = 8, WGM = 8;
__device__ __forceinline__ int lds_byte(int r, int c) { const int st = (r >> 4) * 2 + (c >> 5), rr = r & 15, cc = c & 31, ob = rr * 64 + cc * 2; return st * 1024 + (ob ^ (((ob >> 9) & 1) << 5)); }
__device__ __forceinline__ void stage_rc(int b, int& R, int& C) { const int st = b / 1024, sb = b % 1024, swz = sb ^ (((sb >> 9) & 1) << 5); R = (st >> 1) * 16 + swz / 64; C = (st & 1) * 32 + (swz % 64) / 2; }
__device__ __forceinline__ int perm32(int rho) { const int n = rho >> 4, i = rho & 15; return 8 * (i >> 2) + 4 * n + (i & 3); }

typedef int v8i32 __attribute__((ext_vector_type(8)));
typedef int v4i32 __attribute__((ext_vector_type(4)));
__device__ __forceinline__ v4i32 ifrag_lo(v8i32 f) { return __builtin_shufflevector(f, f, 0, 1, 2, 3); }
__device__ __forceinline__ v4i32 ifrag_hi(v8i32 f) { return __builtin_shufflevector(f, f, 4, 5, 6, 7); }
template <bool I8> struct AccSel { typedef f32x4 T; };
template <> struct AccSel<true> { typedef v4i32 T; };
__device__ __forceinline__ bf16x8 frag_lo(v8i32 f) { const v4i32 a = __builtin_shufflevector(f, f, 0, 1, 2, 3); return __builtin_bit_cast(bf16x8, a); }
__device__ __forceinline__ bf16x8 frag_hi(v8i32 f) { const v4i32 a = __builtin_shufflevector(f, f, 4, 5, 6, 7); return __builtin_bit_cast(bf16x8, a); }
struct Unit { int pm, pn, aux, p0, ne; const char* a; const char* b; };

struct DenseOrder {
    int nM, nN, nwg, G, c, pm0; const char* A; const char* B; size_t astep, acs, bstep;
    __device__ __forceinline__ void init(int nM_, int nN_, int pm0_, int G_, int c_, const void* A_, size_t astep_, size_t acs_, const void* B_, size_t bstep_) {
        asm volatile("" : "+s"(c_));
        nM = nM_; nN = nN_; nwg = nM * nN; G = G_; c = c_; pm0 = pm0_; A = (const char*)A_; B = (const char*)B_; astep = astep_; acs = acs_; bstep = bstep_; }
    __device__ __forceinline__ bool next(int i, Unit& u) const {
        const long L = (long)i * G + c; if (L >= nwg) return false;
        int wgid = (int)L; { const int q = nwg / NXCD, r = nwg % NXCD, xcd = wgid % NXCD, off = wgid / NXCD; wgid = (xcd < r ? xcd * (q + 1) : r * (q + 1) + (xcd - r) * q) + off; }
        const int nig = WGM * nN, gid = wgid / nig, fm = gid * WGM, gsz = (nM - fm) < WGM ? (nM - fm) : WGM;
        u.pm = pm0 + fm + ((wgid % nig) % gsz); u.pn = (wgid % nig) / gsz; u.aux = 0; u.p0 = 0; u.ne = 0;
        u.a = A + (size_t)u.pm * astep + (size_t)u.pn * acs; u.b = B + (size_t)u.pn * bstep; return true;
    }
};
struct MoeOrder {
    int np[8], pb[8], ne[8]; int total, nN, G, c, ncol; const char* A; const char* B; size_t astep, bexp, bstep, ksb;
    __device__ __forceinline__ void init(const unsigned* cnt, int nN_, int G_, int c_, const void* A_, size_t astep_, const void* B_, size_t bexp_, size_t bstep_, int ncol_, size_t ksb_) {
        ncol = ncol_; ksb = ksb_;
        int p = 0;
#pragma unroll
        for (int e = 0; e < 8; ++e) { const int n = (int)__hip_atomic_load(cnt + 64 * e, __ATOMIC_RELAXED, __HIP_MEMORY_SCOPE_AGENT); ne[e] = n; np[e] = (n + 255) >> 8; pb[e] = p; p += np[e]; }
        asm volatile("" : "+s"(c_));
        nN = nN_; total = p * nN; G = G_; c = c_; A = (const char*)A_; B = (const char*)B_; astep = astep_; bexp = bexp_; bstep = bstep_;
    }
    __device__ __forceinline__ bool next(int i, Unit& u) const {
        const int L = i * G + c; if (L >= total) return false;
        int es = 0, cums = 0, nps = 1, pbs = 0, nes = 0, cum = 0;
#pragma unroll
        for (int e = 0; e < 8; ++e) { const int cn = np[e] * nN; const bool in = (L >= cum) && (L < cum + cn); if (in) { es = e; cums = cum; nps = np[e]; pbs = pb[e]; nes = ne[e]; } cum += cn; }
        const int local = L - cums; int pn, pl;
        if (ksb) { pl = local / nN; pn = local - pl * nN; }
        else { pn = local / nps; pl = local - pn * nps; }
        const int ks = pn / ncol, pc = pn - ks * ncol;
        u.pm = pbs + pl; u.pn = pc; u.aux = es | (ks << 8); u.p0 = pl * 256; u.ne = nes;
        u.a = A + (size_t)u.pm * astep + (size_t)ks * ksb; u.b = B + (size_t)es * bexp + (size_t)pc * bstep + (size_t)ks * ksb; return true;
    }
};

template <class Epi, class Sched, int MODE = 0>
__device__ __forceinline__ void gemm_phase(LAS unsigned char* lds, const int K, const int lda, const int ldb, const Sched& S, const Epi& E) {
    constexpr bool FP8 = (MODE == 1), I8 = (MODE == 2);
    typedef typename AccSel<I8>::T acc_t;
    int tid_ = threadIdx.x; asm volatile("" : "+v"(tid_));
    const int tid = tid_, wid = __builtin_amdgcn_readfirstlane(tid >> 6), lane = tid & 63, wr = wid >> 2, wc = wid & 3, fr = lane & 15, fq = lane >> 4;
    int nt = K / BK; asm volatile("" : "+s"(nt));
    unsigned voffA[2], voffB[2];
#pragma unroll
    for (int i = 0; i < 2; ++i) { int R, C; stage_rc(tid * 16 + i * 8192, R, C); const int Rb = Epi::PERM ? ((R & ~31) + perm32(R & 31)) : R;
        voffA[i] = (unsigned)(R * lda + C) * 2u; voffB[i] = (unsigned)(Rb * ldb + C) * 2u; }
    const size_t kstep = (size_t)(BK * 2);
    const size_t hstepA = (size_t)HALF * lda * 2, hstepB = (size_t)HALF * ldb * 2;
    const unsigned ldsw = (unsigned)wid * 1024u;
    const int aoff = lds_byte(wr * 64 + fr, fq * 8), boff = lds_byte(wc * 32 + fr, fq * 8);
#define PG8_SA(b, h) (((b) * 2 + (h)) * HTB)
#define PG8_SB(b, h) ((4 + (b) * 2 + (h)) * HTB)
#define PG8_STAGE(bufoff, gbase, voff) do { _Pragma("unroll") for (int _i = 0; _i < 2; ++_i) \
        __builtin_amdgcn_global_load_lds((const unsigned*)((const char*)(gbase) + (voff)[_i]), (LAS unsigned*)(lds + (bufoff) + ldsw + _i * 8192), 16, 0, 0); } while (0)
#define PG8_LDA(dst, b, h) do { _Pragma("unroll") for (int m = 0; m < 4; ++m) { const v4i32 lo_ = *(const LAS v4i32*)(lds + PG8_SA(b, h) + aoff + m * 2048), hi_ = *(const LAS v4i32*)(lds + PG8_SA(b, h) + aoff + m * 2048 + 1024); dst[m] = __builtin_shufflevector(lo_, hi_, 0, 1, 2, 3, 4, 5, 6, 7); } } while (0)
#define PG8_LDB(dst, b, h) do { _Pragma("unroll") for (int n = 0; n < 2; ++n) { const v4i32 lo_ = *(const LAS v4i32*)(lds + PG8_SB(b, h) + boff + n * 2048), hi_ = *(const LAS v4i32*)(lds + PG8_SB(b, h) + boff + n * 2048 + 1024); dst[n] = __builtin_shufflevector(lo_, hi_, 0, 1, 2, 3, 4, 5, 6, 7); } } while (0)
#define PG8_MMA(ai, bj, At, Bt) do { __builtin_amdgcn_s_setprio(1); _Pragma("unroll") for (int m = 0; m < 4; ++m) _Pragma("unroll") for (int n = 0; n < 2; ++n) { \
        if constexpr (FP8) { asm volatile("v_mfma_scale_f32_16x16x128_f8f6f4 %0, %1, %2, %0, %3, %3 op_sel_hi:[0,0,0]" : "+v"(acc[ai][bj][m][n]) : "v"(Bt[n]), "v"(At[m]), "v"(one8)); } \
        else if constexpr (I8) { acc[ai][bj][m][n] = __builtin_amdgcn_mfma_i32_16x16x64_i8(ifrag_lo(Bt[n]), ifrag_lo(At[m]), acc[ai][bj][m][n], 0, 0, 0); \
               acc[ai][bj][m][n] = __builtin_amdgcn_mfma_i32_16x16x64_i8(ifrag_hi(Bt[n]), ifrag_hi(At[m]), acc[ai][bj][m][n], 0, 0, 0); } \
        else { acc[ai][bj][m][n] = __builtin_amdgcn_mfma_f32_16x16x32_bf16(frag_lo(Bt[n]), frag_lo(At[m]), acc[ai][bj][m][n], 0, 0, 0); \
               acc[ai][bj][m][n] = __builtin_amdgcn_mfma_f32_16x16x32_bf16(frag_hi(Bt[n]), frag_hi(At[m]), acc[ai][bj][m][n], 0, 0, 0); } } \
        __builtin_amdgcn_s_setprio(0); } while (0)
#define PG8_WAIT_V(n) asm volatile("s_waitcnt vmcnt(" #n ")" ::: "memory")
#define PG8_WAIT_L(n) asm volatile("s_waitcnt lgkmcnt(" #n ")" ::: "memory")
#define PG8_BAR __builtin_amdgcn_s_barrier()
#define PG8_SCHED __builtin_amdgcn_sched_barrier(0)
    Unit cur, nxt; int ui = 0;
    if (!S.next(0, cur)) return;
    acc_t acc[2][2][4][2];
#pragma unroll
    for (int a = 0; a < 2; ++a)
#pragma unroll
        for (int b = 0; b < 2; ++b)
#pragma unroll
            for (int m = 0; m < 4; ++m)
#pragma unroll
                for (int n = 0; n < 2; ++n) acc[a][b][m][n] = acc_t{};
    int one8 = 0x7f7f7f7f; asm volatile("" : "+v"(one8));
    v8i32 At[4], B0[2], B1[2];
    const char* cA = cur.a; const char* cB = cur.b;
    typename Epi::Pre pre = E.pre(cur, wr, wc, fr, fq);
    PG8_STAGE(PG8_SB(0, 0), cB, voffB); PG8_STAGE(PG8_SB(0, 1), cB + hstepB, voffB); PG8_STAGE(PG8_SA(0, 0), cA, voffA); PG8_STAGE(PG8_SA(0, 1), cA + hstepA, voffA);
    if (wr == 1) PG8_BAR;
    PG8_WAIT_V(2); PG8_BAR;
    PG8_STAGE(PG8_SB(1, 0), cB + kstep, voffB); PG8_STAGE(PG8_SA(1, 0), cA + kstep, voffA); PG8_STAGE(PG8_SB(1, 1), cB + hstepB + kstep, voffB);
    PG8_WAIT_V(6); PG8_BAR;
    for (;;) {
        const bool has_next = S.next(ui + 1, nxt);
        const char* nA = has_next ? nxt.a : cA; const char* nB = has_next ? nxt.b : cB;
        for (int t = 0; t < nt; t += 2) {
            const bool last = (t == nt - 2);
            const char* a1 = cA + (size_t)(t + 1) * kstep;
            const char* a2 = last ? nA : cA + (size_t)(t + 2) * kstep; const char* b2 = last ? nB : cB + (size_t)(t + 2) * kstep;
            const char* a3 = a2 + kstep; const char* b3 = b2 + kstep;
            PG8_LDB(B0, 0, 0); PG8_LDB(B1, 0, 1); PG8_SCHED; PG8_LDA(At, 0, 0); PG8_STAGE(PG8_SA(1, 1), a1 + hstepA, voffA);
            PG8_WAIT_V(8); PG8_WAIT_L(0); PG8_BAR; PG8_MMA(0, 0, At, B0); PG8_MMA(0, 1, At, B1); PG8_BAR; PG8_SCHED;
            PG8_LDA(At, 0, 1); PG8_STAGE(PG8_SB(0, 0), b2, voffB); PG8_STAGE(PG8_SB(0, 1), b2 + hstepB, voffB); PG8_STAGE(PG8_SA(0, 0), a2, voffA);
            PG8_WAIT_V(8); PG8_WAIT_L(0); PG8_BAR; PG8_MMA(1, 0, At, B0); PG8_MMA(1, 1, At, B1); PG8_BAR; PG8_SCHED;
            PG8_LDB(B0, 1, 0); PG8_LDB(B1, 1, 1); PG8_SCHED; PG8_LDA(At, 1, 0); PG8_STAGE(PG8_SA(0, 1), a2 + hstepA, voffA);
            PG8_WAIT_V(8); PG8_WAIT_L(0); PG8_BAR; PG8_MMA(0, 0, At, B0); PG8_MMA(0, 1, At, B1); PG8_BAR; PG8_SCHED;
            PG8_LDA(At, 1, 1); PG8_STAGE(PG8_SB(1, 0), b3, voffB); PG8_STAGE(PG8_SB(1, 1), b3 + hstepB, voffB); PG8_STAGE(PG8_SA(1, 0), a3, voffA);
            PG8_WAIT_V(8); PG8_WAIT_L(0); PG8_BAR; PG8_MMA(1, 0, At, B0); PG8_MMA(1, 1, At, B1); PG8_BAR; PG8_SCHED;
        }
        if constexpr (FP8) asm volatile("s_nop 15\n\ts_nop 7" ::: "memory");
        if (wr == 0) PG8_BAR;
        { int te_ = threadIdx.x; asm volatile("" : "+v"(te_));
          const int le_ = te_ & 63; E(acc, cur, wr, wc, le_ & 15, le_ >> 4, pre); }
        if (!has_next) break;
#pragma unroll
        for (int a = 0; a < 2; ++a)
#pragma unroll
            for (int b = 0; b < 2; ++b)
#pragma unroll
                for (int m = 0; m < 4; ++m)
#pragma unroll
                    for (int n = 0; n < 2; ++n) acc[a][b][m][n] = acc_t{};
        cur = nxt; cA = nA; cB = nB; ++ui; pre = E.pre(cur, wr, wc, fr, fq);
        if (wr == 1) PG8_BAR;
    }
    PG8_WAIT_V(0);
    PG8_BAR;
#undef PG8_SA
#undef PG8_SB
#undef PG8_STAGE
#undef PG8_LDA
#undef PG8_LDB
#undef PG8_MMA
#undef PG8_WAIT_V
#undef PG8_WAIT_L
#undef PG8_BAR
#undef PG8_SCHED
}

__device__ __forceinline__ u32x4 pack8(const f32x4 v0, const f32x4 v1) { u32x4 w; w.x = cvtpk(v0[0], v0[1]); w.y = cvtpk(v0[2], v0[3]); w.z = cvtpk(v1[0], v1[1]); w.w = cvtpk(v1[2], v1[3]); return w; }

__device__ __forceinline__ void rope8(f32x4& v0, f32x4& v1, int t, int fq, const float* rope) {
    const int pos = (fq < 2) ? (t >> 6) : (t & (GRID_W - 1));
    const float* tb = rope + pos * 16;
    const f32x4 c0 = *(const f32x4*)(tb), c1 = *(const f32x4*)(tb + 4), s0 = *(const f32x4*)(tb + 8), s1 = *(const f32x4*)(tb + 12);
    f32x4 u0, u1;
#pragma unroll
    for (int i = 0; i < 4; ++i) { u0[i] = __shfl_xor(v0[i], 16); u1[i] = __shfl_xor(v1[i], 16); }
    if (fq & 1) { v0 = u0 * s0 + v0 * c0; v1 = u1 * s1 + v1 * c1; }
    else        { v0 = v0 * c0 - u0 * s0; v1 = v1 * c1 - u1 * s1; }
}

struct EpiProj {
    static constexpr bool PERM = true;
    bf16* PROJ; float* SSQ; bf16* KM; const float* rope; float* kmax; const float* hsc; const float* wsc;
    struct Pre { float sw[2]; float hs[8]; };
    __device__ __forceinline__ Pre pre(const Unit& u, int wr, int wc, int fr, int fq) const {
        Pre p; const int wrow = u.pn * BM + wc * 32 + 8 * fq, row0 = u.pm * BM + wr * 64 + fr;
        p.sw[0] = wsc[wrow]; p.sw[1] = wsc[wrow + HALF];
#pragma unroll
        for (int q = 0; q < 8; ++q) p.hs[q] = hsc[row0 + (q >> 2) * HALF + (q & 3) * 16];
        return p;
    }
    __device__ __forceinline__ void operator()(const v4i32 (&acc)[2][2][4][2], const Unit& u, int wr, int wc, int fr, int fq, const Pre& p) const {
        const int row0 = u.pm * BM + wr * 64 + fr, col0 = u.pn * BM + wc * 32 + 8 * fq; float kr2 = 0.f, ka2[2] = {0.f, 0.f};
#pragma unroll
        for (int ai = 0; ai < 2; ++ai)
#pragma unroll
            for (int m = 0; m < 4; ++m) { const int row = row0 + ai * HALF + m * 16;
#pragma unroll
                for (int bj = 0; bj < 2; ++bj) { const float sc_ = p.hs[ai * 4 + m] * p.sw[bj];
                    f32x4 v0 = __builtin_convertvector(acc[ai][bj][m][0], f32x4) * sc_, v1 = __builtin_convertvector(acc[ai][bj][m][1], f32x4) * sc_;
                    *(u32x4*)(PROJ + (size_t)row * PROJ_LD + col0 + bj * HALF) = pack8(v0, v1);
                    if (u.pn == 2 || u.pn == 3) { float s2 = (v0[0] * v0[0] + v0[1] * v0[1]) + (v0[2] * v0[2] + v0[3] * v0[3]) + (v1[0] * v1[0] + v1[1] * v1[1]) + (v1[2] * v1[2] + v1[3] * v1[3]);
                        s2 += __shfl_xor(s2, 16); s2 += __shfl_xor(s2, 32); ka2[bj] = fmaxf(ka2[bj], s2); }
                    if (u.pn == 6 || (u.pn == 7 && bj == 0)) {
                        float ss = (v0[0] * v0[0] + v0[1] * v0[1]) + (v0[2] * v0[2] + v0[3] * v0[3]) + (v1[0] * v1[0] + v1[1] * v1[1]) + (v1[2] * v1[2] + v1[3] * v1[3]);
                        ss += __shfl_xor(ss, 16); ss += __shfl_xor(ss, 32);
                        if (fq == 0) SSQ[(size_t)row * 16 + (u.pn == 6 ? bj * 4 + wc : 8 + wc)] = ss;
                    }
                    if (u.pn == 7 && bj == 1 && wc == 0) {
                        { float s2 = (v0[0] * v0[0] + v0[1] * v0[1]) + (v0[2] * v0[2] + v0[3] * v0[3]) + (v1[0] * v1[0] + v1[1] * v1[1]) + (v1[2] * v1[2] + v1[3] * v1[3]);
                          s2 += __shfl_xor(s2, 16); s2 += __shfl_xor(s2, 32); kr2 = fmaxf(kr2, s2); }
                        if (u.pm >= 1) rope8(v0, v1, row - NCTX, fq, rope);
                        const u32x4 w = pack8(v0, v1);
#pragma unroll
                        for (int h = 0; h < 8; ++h) *(u32x4*)(KM + (size_t)row * KM_LD + h * 96 + 64 + 8 * fq) = w;
                    }
                } }
        if (u.pn == 2 || u.pn == 3) {
#pragma unroll
            for (int bj = 0; bj < 2; ++bj) { float m = ka2[bj];
#pragma unroll
                for (int o = 1; o < 16; o <<= 1) m = fmaxf(m, __shfl_xor(m, o));
                if ((fr | fq) == 0) kmax[(17 + ((u.pn - 2) * 4 + bj * 2 + (wc >> 1)) * 2 + (wc & 1)) * 130 + u.pm * 2 + wr] = m; }
        }
        if (u.pn == 7 && wc == 0) {
#pragma unroll
            for (int o = 1; o < 16; o <<= 1) kr2 = fmaxf(kr2, __shfl_xor(kr2, o));
            if ((fr | fq) == 0) kmax[u.pm * 2 + wr] = kr2;
        }
    }
};
struct EpiUp {
    static constexpr bool PERM = true;
    struct Pre {}; __device__ __forceinline__ Pre pre(const Unit&, int, int, int, int) const { return Pre{}; }
    const float* SSQ; bf16* QM; bf16* KM; bf16* VM; const float* rope; float* kmax;
    __device__ __forceinline__ void operator()(const f32x4 (&acc)[2][2][4][2], const Unit& u, int wr, int wc, int fr, int fq, const Pre&) const {
        const int row0 = u.pm * BM + wr * 64 + fr; const bool isq = u.pn < 3; float kn2[2] = {0.f, 0.f};
#pragma unroll
        for (int ai = 0; ai < 2; ++ai)
#pragma unroll
            for (int m = 0; m < 4; ++m) { const int row = row0 + ai * HALF + m * 16; float r;
                if (isq) { const f32x4 a = *(const f32x4*)(SSQ + (size_t)row * 16), b = *(const f32x4*)(SSQ + (size_t)row * 16 + 4);
                    r = rsqrtf(((a[0] + a[1]) + (a[2] + a[3]) + (b[0] + b[1]) + (b[2] + b[3])) * (1.f / 256.f) + RMS_EPS); }
                else { const f32x4 a = *(const f32x4*)(SSQ + (size_t)row * 16 + 8); r = rsqrtf(((a[0] + a[1]) + (a[2] + a[3])) * (1.f / 128.f) + RMS_EPS); }
#pragma unroll
                for (int bj = 0; bj < 2; ++bj) { const int grp = u.pn * BM + bj * HALF + wc * 32, c0 = grp + 8 * fq;
                    f32x4 v0 = acc[ai][bj][m][0] * r, v1 = acc[ai][bj][m][1] * r;
                    if (isq) { if ((grp % 96) == 64 && u.pm >= 1) rope8(v0, v1, row - NCTX, fq, rope);
                        *(u32x4*)(QM + (size_t)row * QM_LD + c0) = pack8(v0, v1); }
                    else { const int cc = c0 - 768, head = cc >> 7, within = cc & 127;
                        if (within < 64) { *(u32x4*)(KM + (size_t)row * KM_LD + head * 96 + within) = pack8(v0, v1);
                            float s2 = (v0[0] * v0[0] + v0[1] * v0[1]) + (v0[2] * v0[2] + v0[3] * v0[3]) + (v1[0] * v1[0] + v1[1] * v1[1]) + (v1[2] * v1[2] + v1[3] * v1[3]);
                            s2 += __shfl_xor(s2, 16); s2 += __shfl_xor(s2, 32); kn2[bj] = fmaxf(kn2[bj], s2); }
                        else *(u32x4*)(VM + (size_t)row * VM_LD + head * 64 + within - 64) = pack8(v0, v1); }
                } }
        if (!isq && wc < 2) {
#pragma unroll
            for (int bj = 0; bj < 2; ++bj) { float m = kn2[bj];
#pragma unroll
                for (int o = 1; o < 16; o <<= 1) m = fmaxf(m, __shfl_xor(m, o));
                if ((fr | fq) == 0) kmax[(1 + ((u.pn - 3) * 2 + bj) * 2 + wc) * 130 + u.pm * 2 + wr] = m; }
        }
    }
};
struct EpiResid {
    static constexpr bool PERM = false;
    struct Pre {}; __device__ __forceinline__ Pre pre(const Unit&, int, int, int, int) const { return Pre{}; }
    float* Xl; float* Xc; const float* gate_lat; const float* gate_ctx; const float* Xsrc;
    float sc = 1.f;
    __device__ __forceinline__ void operator()(const f32x4 (&acc)[2][2][4][2], const Unit& u, int wr, int wc, int fr, int fq, const Pre&) const {
        const bool isctx = (u.pm == 0);
        float* Xb = isctx ? Xc : Xl + (size_t)(u.pm - 1) * BM * D; const float* gv = isctx ? gate_ctx : gate_lat;
        const float* Xs = isctx ? Xc : Xsrc + (size_t)(u.pm - 1) * BM * D;
        const int col0 = u.pn * BM + wc * 32 + 4 * fq;
        f32x4 g[2][2];
#pragma unroll
        for (int bj = 0; bj < 2; ++bj)
#pragma unroll
            for (int n = 0; n < 2; ++n) g[bj][n] = *(const f32x4*)(gv + col0 + bj * HALF + n * 16) * sc;
#pragma unroll
        for (int ai = 0; ai < 2; ++ai)
#pragma unroll
            for (int m = 0; m < 4; ++m) { float* xr = Xb + (size_t)(ai * HALF + wr * 64 + m * 16 + fr) * D + col0; const float* xs = Xs + (size_t)(ai * HALF + wr * 64 + m * 16 + fr) * D + col0;
#pragma unroll
                for (int bj = 0; bj < 2; ++bj)
#pragma unroll
                    for (int n = 0; n < 2; ++n) { f32x4 x = *(const f32x4*)(xs + bj * HALF + n * 16); x = x * ALPHA + g[bj][n] * acc[ai][bj][m][n]; *(f32x4*)(xr + bj * HALF + n * 16) = x; }
                if (m & 1) asm volatile("" ::: "memory"); }
    }
};
__device__ __forceinline__ float swi(float g, float up) { return g * up * __builtin_amdgcn_rcpf(1.f + __builtin_amdgcn_exp2f(-g * LOG2E)); }
struct EpiSwigluI8 {
    static constexpr bool PERM = true;
    bf16* HID; int ldh; const float* hsc; const float* wsc0; int wstride; bool out8;
    struct Pre { float sg, su; float hs[8]; };
    __device__ __forceinline__ Pre pre(const Unit& u, int wr, int wc, int fr, int fq) const {
        Pre p; const float* wsc = wsc0 + (size_t)(u.aux & 255) * wstride; const int wrow = u.pn * BM + wc * 32 + 8 * fq, row0 = u.pm * BM + wr * 64 + fr;
        p.sg = wsc[wrow]; p.su = wsc[wrow + HALF];
#pragma unroll
        for (int q = 0; q < 8; ++q) p.hs[q] = hsc[row0 + (q >> 2) * HALF + (q & 3) * 16];
        return p;
    }
    __device__ __forceinline__ void operator()(const v4i32 (&acc)[2][2][4][2], const Unit& u, int wr, int wc, int fr, int fq, const Pre& p) const {
        const int row0 = u.pm * BM + wr * 64 + fr, col0 = u.pn * HALF + wc * 32 + 8 * fq;
#pragma unroll
        for (int ai = 0; ai < 2; ++ai)
#pragma unroll
            for (int m = 0; m < 4; ++m) { const int row = row0 + ai * HALF + m * 16; const float cg = p.hs[ai * 4 + m] * p.sg, cu = p.hs[ai * 4 + m] * p.su; f32x4 h0, h1;
                const f32x2 cgm = {-LOG2E * cg, -LOG2E * cg}, cgu = {cg * cu, cg * cu};
#pragma unroll
                for (int n = 0; n < 2; ++n)
#pragma unroll
                    for (int i = 0; i < 4; i += 2) { const f32x2 g2 = {(float)acc[ai][0][m][n][i], (float)acc[ai][0][m][n][i + 1]}, u2 = {(float)acc[ai][1][m][n][i], (float)acc[ai][1][m][n][i + 1]};
                        const f32x2 t = g2 * cgm; f32x2 d; d.x = __builtin_amdgcn_exp2f(t.x); d.y = __builtin_amdgcn_exp2f(t.y); d = d + 1.0f;
                        f32x2 r; r.x = __builtin_amdgcn_rcpf(d.x); r.y = __builtin_amdgcn_rcpf(d.y);
                        const f32x2 o2 = (g2 * u2) * (r * cgu);
                        if (n == 0) { h0[i] = o2.x; h0[i + 1] = o2.y; } else { h1[i] = o2.x; h1[i + 1] = o2.y; } }
                if (out8) { int a = 0, b = 0; a = __builtin_amdgcn_cvt_pk_fp8_f32(h0[0], h0[1], a, false); a = __builtin_amdgcn_cvt_pk_fp8_f32(h0[2], h0[3], a, true);
                    b = __builtin_amdgcn_cvt_pk_fp8_f32(h1[0], h1[1], b, false); b = __builtin_amdgcn_cvt_pk_fp8_f32(h1[2], h1[3], b, true);
                    *(u32x2*)((unsigned char*)HID + (size_t)row * ldh + col0) = (u32x2){(unsigned)a, (unsigned)b}; }
                else *(u32x4*)(HID + (size_t)row * ldh + col0) = pack8(h0, h1); }
    }
};
struct EpiMoeDown {
    static constexpr bool PERM = true;
    struct Pre {}; __device__ __forceinline__ Pre pre(const Unit&, int, int, int, int) const { return Pre{}; }
    bf16* OUT0; bf16* OUT1; const float* listW; float sc;
    __device__ __forceinline__ void operator()(const f32x4 (&acc)[2][2][4][2], const Unit& u, int wr, int wc, int fr, int fq, const Pre&) const {
        const int col0 = u.pn * BM + wc * 32 + 8 * fq; const int e = u.aux & 255; bf16* OUT = (u.aux >> 8) ? OUT1 : OUT0;
#pragma unroll
        for (int ai = 0; ai < 2; ++ai)
#pragma unroll
            for (int m = 0; m < 4; ++m) { const int r = ai * HALF + wr * 64 + m * 16 + fr, p = u.p0 + r;
                const float w = (p < u.ne) ? listW[(size_t)e * NTOK + p] * sc : 0.f;
#pragma unroll
                for (int bj = 0; bj < 2; ++bj) *(u32x4*)(OUT + (size_t)(u.pm * BM + r) * D + col0 + bj * HALF) = pack8(acc[ai][bj][m][0] * w, acc[ai][bj][m][1] * w); }
    }
};
}


namespace mla {
using f32x16_t = f32x16;
constexpr int NW = 8, QBLK = 32, KVBLK = 64;
constexpr int NSLOT = 3, VSLOT = 8192;
template <int DQK> struct Lay {
    static constexpr int KSLOT = 64 * DQK * 2, LDS_K = 0, LDS_V = NSLOT * KSLOT, LDS_WS = LDS_V + NSLOT * VSLOT, LDS_OST = LDS_WS + NW * 64 * 4, LDS_BIAS = LDS_OST + NW * 4096, LDS_BYTES = LDS_BIAS + 2048 + 64;
};
#define SBAR() __builtin_amdgcn_sched_barrier(0)
__device__ __forceinline__ int crow(int r, int hi) { return (r & 3) + 8 * (r >> 2) + 4 * hi; }
__device__ __forceinline__ void glds16(const void* gbase  , unsigned voff  , unsigned lds_dst) { unsigned keep;
    asm volatile("s_mov_b32 %0, m0\n\ts_mov_b32 m0, %2\n\ts_nop 0\n\tglobal_load_lds_dwordx4 %1, %3\n\ts_mov_b32 m0, %0" : "=&s"(keep) : "v"(voff), "s"(lds_dst), "s"(gbase) : "memory"); }
__device__ __forceinline__ float max3f(float a, float b, float c) { float r; asm("v_max3_f32 %0, %1, %2, %3" : "=v"(r) : "v"(a), "v"(b), "v"(c)); return r; }
__device__ __forceinline__ float max2f(float a, float b) { float r; asm("v_max_f32_e32 %0, %1, %2" : "=v"(r) : "v"(a), "v"(b)); return r; }
__device__ __forceinline__ float fadd_s(float a, float b) { float r; asm("v_add_f32_e32 %0, %1, %2" : "=v"(r) : "v"(a), "v"(b)); return r; }
__device__ __forceinline__ float fsub_s(float a, float b) { float r; asm("v_sub_f32_e32 %0, %1, %2" : "=v"(r) : "v"(a), "v"(b)); return r; }
#define WAIT_BAR2(NL, NO) do { if (lead) asm volatile("s_waitcnt vmcnt(" #NL ") lgkmcnt(0)\n\ts_barrier" ::: "memory"); else asm volatile("s_waitcnt vmcnt(" #NO ") lgkmcnt(0)\n\ts_barrier" ::: "memory"); } while (0)
typedef LAS const char* lds_cptr;
typedef short v4i16_t __attribute__((ext_vector_type(4)));
__device__ __forceinline__ void kload2(bf16x8* kf, lds_cptr kp, int j) { kf[2 * j] = *(const LAS bf16x8*)(kp + j * 2048); kf[2 * j + 1] = *(const LAS bf16x8*)(kp + j * 2048 + 512); }
__device__ __forceinline__ s16x4 vtr(lds_cptr p) { return __builtin_bit_cast(s16x4, __builtin_amdgcn_ds_read_tr16_b64_v4i16((LAS v4i16_t*)p)); }
__device__ __forceinline__ float rowmax(const f32x16& p0, const f32x16& p1) {
    float a = max3f(p0[0], p0[1], p1[0]), b = max3f(p0[2], p0[3], p1[1]); a = max3f(a, p1[2], p1[3]);
#pragma unroll
    for (int r = 4; r < 16; r += 4) { a = max3f(a, p0[r], p0[r + 1]); b = max3f(b, p0[r + 2], p0[r + 3]); a = max3f(a, p1[r], p1[r + 1]); b = max3f(b, p1[r + 2], p1[r + 3]); }
    const float m = max2f(a, b);
    auto rr = __builtin_amdgcn_permlane32_swap(__float_as_uint(m), __float_as_uint(m), false, false);
    return max2f(__uint_as_float(rr[0]), __uint_as_float(rr[1]));
}
__device__ __forceinline__ void pv(f32x16* o, unsigned vb, bf16x8 pa0, bf16x8 pa1, bf16x8 pa2, bf16x8 pa3) {
#pragma unroll
    for (int d0 = 0; d0 < 2; ++d0) { s16x4 lo[4], hi[4];
#pragma unroll
        for (int ks = 0; ks < 4; ++ks) {
            asm volatile("ds_read_b64_tr_b16 %0,%1 offset:%c2" : "=&v"(lo[ks]) : "v"(vb), "i"(d0 * 4096 + ks * 1024) : "memory");
            asm volatile("ds_read_b64_tr_b16 %0,%1 offset:%c2" : "=&v"(hi[ks]) : "v"(vb), "i"(d0 * 4096 + ks * 1024 + 512) : "memory"); }
        asm volatile("s_waitcnt lgkmcnt(0)" ::: "memory"); SBAR();
#define PK(k) (bf16x8){lo[k][0], lo[k][1], lo[k][2], lo[k][3], hi[k][0], hi[k][1], hi[k][2], hi[k][3]}
        o[d0] = __builtin_amdgcn_mfma_f32_32x32x16_bf16(pa0, PK(0), o[d0], 0, 0, 0);
        o[d0] = __builtin_amdgcn_mfma_f32_32x32x16_bf16(pa1, PK(1), o[d0], 0, 0, 0);
        o[d0] = __builtin_amdgcn_mfma_f32_32x32x16_bf16(pa2, PK(2), o[d0], 0, 0, 0);
        o[d0] = __builtin_amdgcn_mfma_f32_32x32x16_bf16(pa3, PK(3), o[d0], 0, 0, 0);
#undef PK
    }
}
template <int DQK, bool NA, int LDQ, int LDK, int LDV, int LDO>
__device__ __forceinline__ void attn_unit(const bf16* Qw0, const bf16* __restrict__ Kh, const bf16* __restrict__ Vh, bf16* Ow0, const int NT, const float k2max  ,
                                          const int krs, const int qgrow, const float* __restrict__ biasg, LAS char* shm) {
    typedef Lay<DQK> L; constexpr int NF = DQK / 16, KSLOT = L::KSLOT, LDS_K = L::LDS_K, LDS_V = L::LDS_V, LDS_WS = L::LDS_WS, LDS_OST = L::LDS_OST;
    int tid_ = threadIdx.x; asm volatile("" : "+v"(tid_));
    const int tid = tid_, lane = tid & 63, r32 = lane & 31, hi = lane >> 5; const int wid = __builtin_amdgcn_readfirstlane(tid >> 6);
    const bool lead = (DQK == 96) && (wid < 4);
    LAS float* biasL = (LAS float*)(shm + L::LDS_BIAS); LAS float* bmaxL = (LAS float*)(shm + L::LDS_BIAS + 2048);
    const int qr_g = qgrow + (wid >> 1), qc = 32 * (wid & 1) + r32, rs = min(max(qr_g - 4, 0), 248), cs = min(max(qc - 8, 0), 48);
    if (NA) { float bv = -INFINITY; if (tid < 465) { bv = biasg[tid] * LOG2E; biasL[tid] = bv; }
#pragma unroll
        for (int o = 1; o < 64; o <<= 1) bv = fmaxf(bv, __shfl_xor(bv, o));
        if (lane == 0) bmaxL[wid] = bv; }
    const bf16* Qw = Qw0 + (size_t)(wid * QBLK) * LDQ;
    const unsigned lds0 = (unsigned)(uintptr_t)shm;
    LAS float* wsf = (LAS float*)(shm + LDS_WS) + wid * 64;
    const unsigned koff = (unsigned)(lane * LDK + wid * 8) * 2u;
    const unsigned voff = (unsigned)((16 * (wid & 3) + (lane >> 2)) * LDV + (wid >> 2) * 32 + (lane & 3) * 8) * 2u;
    const unsigned kdst = lds0 + LDS_K + wid * 1024, vdst = lds0 + LDS_V + wid * 1024;
#define TROW(t) ((NA && (t) >= 4) ? (NCTX + 64 * (krs + (t) - 4)) : 64 * (t))
#define DMA_K(t, slot) do { const bf16* kb_ = Kh + (size_t)TROW(t) * LDK; glds16(kb_, koff, (unsigned)__builtin_amdgcn_readfirstlane(kdst + (slot))); \
        if (lead) glds16(kb_ + 64, koff, (unsigned)__builtin_amdgcn_readfirstlane(kdst + 8192 + (slot))); } while (0)
#define DMA_V(t, vslot) glds16(Vh + (size_t)TROW(t) * LDV, voff, (unsigned)__builtin_amdgcn_readfirstlane(vdst + (vslot)))
    const unsigned vb0 = lds0 + LDS_V + ((lane >> 4) & 1) * 32 + (lane & 3) * 8 + (4 * hi + ((lane & 15) >> 2)) * 64;
    const LAS char* Kbase = shm + LDS_K; bf16x8 kf[2 * NF];
    const lds_cptr shm3 = (lds_cptr)shm; const lds_cptr kp0 = shm3 + LDS_K + hi * 1024 + r32 * 16;
    const lds_cptr vp0 = shm3 + LDS_V + ((lane >> 4) & 1) * 32 + (lane & 3) * 8 + (4 * hi + ((lane & 15) >> 2)) * 64;
    DMA_K(0, 0); DMA_V(0, 0); DMA_K(1, KSLOT);
    bf16x8 qr[NF];
#pragma unroll
    for (int d0 = 0; d0 < NF; ++d0) qr[d0] = *(const bf16x8*)(&Qw[(size_t)r32 * LDQ + d0 * 16 + hi * 8]);
    float l_reg = 0.f; f32x16 o[2]; o[0] = f32x16{}; o[1] = f32x16{}; f32x16 negm;
    float q2 = 0.f;
#pragma unroll
    for (int d0 = 0; d0 < NF; ++d0) { const u32x4 w = __builtin_bit_cast(u32x4, qr[d0]);
#pragma unroll
      for (int i = 0; i < 4; ++i) { const float a = bf_lo(w[i]), c = bf_hi(w[i]); q2 += a * a + c * c; } }
    { auto rr = __builtin_amdgcn_permlane32_swap(__float_as_uint(q2), __float_as_uint(q2), false, false); q2 = __uint_as_float(rr[0]) + __uint_as_float(rr[1]); }
#define START(P0, P1) do { _Pragma("unroll") for (int r = 0; r < 16; ++r) P0[r] = __builtin_amdgcn_exp2f(P0[r]); } while (0)
#define RESC() do { } while (0)
    f32x16 pA0, pA1, pB0, pB1;
    int ks_prev = 0, ks_cur = 0, ks_next = KSLOT, vs_prev = 0, vs_cur = 0, vs_next = VSLOT;
#define ROT() do { ks_prev = ks_cur; ks_cur = ks_next; ks_next = (ks_next == (NSLOT - 1) * KSLOT) ? 0 : ks_next + KSLOT; \
                   vs_prev = vs_cur; vs_cur = vs_next; vs_next = (vs_next == (NSLOT - 1) * VSLOT) ? 0 : vs_next + VSLOT; } while (0)
    DMA_K(2, 2 * KSLOT);
    WAIT_BAR2(5, 3);
    { float mref = sqrtf(q2 * k2max) * 1.01f + 0.01f;
      if (NA) { float bm = bmaxL[0];
#pragma unroll
        for (int w = 1; w < 8; ++w) bm = fmaxf(bm, bmaxL[w]);
        mref += fmaxf(bm, 0.f); }
      mref = fminf(mref, 100.f);
#pragma unroll
      for (int r = 0; r < 16; ++r) negm[r] = -mref;
      asm volatile("" : "+v"(negm)); }
    { const LAS char* kb = Kbase + hi * 1024 + r32 * 16;
#pragma unroll
      for (int d0 = 0; d0 < NF; ++d0) { const bf16x8 b0 = *(const LAS bf16x8*)(kb + d0 * 2048); const bf16x8 b1 = *(const LAS bf16x8*)(kb + d0 * 2048 + 512);
        if (d0 == 0) { pA0 = __builtin_amdgcn_mfma_f32_32x32x16_bf16(b0, qr[0], negm, 0, 0, 0); pA1 = __builtin_amdgcn_mfma_f32_32x32x16_bf16(b1, qr[0], negm, 0, 0, 0); }
        else { pA0 = __builtin_amdgcn_mfma_f32_32x32x16_bf16(b0, qr[d0], pA0, 0, 0, 0); pA1 = __builtin_amdgcn_mfma_f32_32x32x16_bf16(b1, qr[d0], pA1, 0, 0, 0); } } }
    asm volatile("s_nop 15\n\ts_nop 7" : "+v"(pA0), "+v"(pA1));
    START(pA0, pA1);
#pragma unroll
    for (int r = 0; r < 16; ++r) pA1[r] = __builtin_amdgcn_exp2f(pA1[r]);
    WAIT_BAR2(0, 0);
    DMA_K(3, 0); DMA_V(1, VSLOT);
    ROT();
#pragma unroll
    for (int j = 0; j < NF; ++j) kload2(kf, kp0 + ks_cur, j);
    WAIT_BAR2(3, 2);
    s16x4 vlo[8], vhi[8]; u32x4 pw0, pw1, pw2, pw3;
#define PKW(P, B) cvtpk(P[B], P[B + 1])
#define PAF(k) __builtin_bit_cast(bf16x8, pw##k)
#define VFR(i) (bf16x8){vlo[i][0], vlo[i][1], vlo[i][2], vlo[i][3], vhi[i][0], vhi[i][1], vhi[i][2], vhi[i][3]}
#define PIN(x) asm volatile("" : "+v"(x))
#define MX3(a, b, c) __builtin_fmaxf(__builtin_fmaxf((a), (b)), (c))
#define GAPA(MF, A0, A1, A2, A3, W0, W1, PW) do { MF; sacc += A0; sacc += A1; sacc += A2; sacc += A3; PIN(sacc); W0; W1; PIN(PW); SBAR(); } while (0)
#define GAPM(MF) do { MF; SBAR(); } while (0)
#define EX(v) __builtin_amdgcn_exp2f(v)
#define GAPB(MF, X, B) do { MF; X[B] = EX(X[B]); X[B + 1] = EX(X[B + 1]); X[B + 2] = EX(X[B + 2]); X[B + 3] = EX(X[B + 3]); PIN(X); SBAR(); } while (0)
#define VRD(i) do { vlo[i] = vtr(vp_ + (((i) >> 2) * 4096 + ((i) & 3) * 1024)); vhi[i] = vtr(vp_ + (((i) >> 2) * 4096 + ((i) & 3) * 1024 + 512)); } while (0)
#define KRD(G, j) do { if (G) { kload2(kf, kp0 + ks_next, j); SBAR(); } } while (0)
#define MF32(a, b, c) __builtin_amdgcn_mfma_f32_32x32x16_bf16(a, b, c, 0, 0, 0)
#define NAMASK(C0, C1, t) do { if (NA && (t) >= 4) { const int kr_ = krs + (t) - 4; const bool live_ = (kr_ >= rs) && (kr_ < rs + 8);        \
      asm volatile("s_nop 15\n\ts_nop 7" : "+v"(C0), "+v"(C1)); \
      if (!live_) { _Pragma("unroll") for (int r = 0; r < 16; ++r) { C0[r] = -INFINITY; C1[r] = -INFINITY; } } \
      else { const LAS float* br_ = biasL + (kr_ - qr_g + 7) * 31 + (15 - qc); \
        _Pragma("unroll") for (int r = 0; r < 16; ++r) { const int kc_ = crow(r, hi); const int c0_ = min(max(kc_, cs), cs + 15), c1_ = min(max(kc_ + 32, cs), cs + 15); \
            const float b0_ = br_[c0_], b1_ = br_[c1_]; C0[r] = (c0_ == kc_) ? C0[r] + b0_ : -INFINITY; C1[r] = (c1_ == kc_ + 32) ? C1[r] + b1_ : -INFINITY; } } } } while (0)
#define STEP(C0, C1, P0, P1, t, GK, GV, GL) do { SBAR(); \
    const lds_cptr vp_ = vp0 + vs_prev; \
    VRD(0); SBAR(); float sacc = (P0[0] + P0[1]); \
    GAPA(C0 = MF32(kf[0], qr[0], negm), P0[2], P0[3], P0[4], P0[5],     pw0[0] = PKW(P0, 0), pw0[1] = PKW(P0, 2), pw0); \
    VRD(4); SBAR(); GAPA(C1 = MF32(kf[1], qr[0], negm), P0[6], P0[7], P0[8], P0[9],     pw0[2] = PKW(P0, 4), pw0[3] = PKW(P0, 6), pw0); \
    VRD(1); SBAR(); GAPA(C0 = MF32(kf[2], qr[1], C0),   P0[10], P0[11], P0[12], P0[13], pw1[0] = PKW(P0, 8), pw1[1] = PKW(P0, 10), pw1); \
    VRD(5); SBAR(); GAPA(C1 = MF32(kf[3], qr[1], C1),   P0[14], P0[15], P1[0], P1[1],   pw1[2] = PKW(P0, 12), pw1[3] = PKW(P0, 14), pw1); \
    VRD(2); SBAR(); GAPA(C0 = MF32(kf[4], qr[2], C0),   P1[2], P1[3], P1[4], P1[5],     pw2[0] = PKW(P1, 0), pw2[1] = PKW(P1, 2), pw2); \
    VRD(6); SBAR(); GAPA(C1 = MF32(kf[5], qr[2], C1),   P1[6], P1[7], P1[8], P1[9],     pw2[2] = PKW(P1, 4), pw2[3] = PKW(P1, 6), pw2); \
    VRD(3); SBAR(); GAPA(C0 = MF32(kf[6], qr[3], C0),   P1[10], P1[11], P1[12], P1[13], pw3[0] = PKW(P1, 8), pw3[1] = PKW(P1, 10), pw3); \
    VRD(7); SBAR(); GAPA(C1 = MF32(kf[7], qr[3], C1),   P1[14], P1[15], 0.f, 0.f,       pw3[2] = PKW(P1, 12), pw3[3] = PKW(P1, 14), pw3); \
    if constexpr (NF == 6) { GAPM(C0 = MF32(kf[2 * NF - 4], qr[NF - 2], C0)); GAPM(C1 = MF32(kf[2 * NF - 3], qr[NF - 2], C1)); GAPM(C0 = MF32(kf[2 * NF - 2], qr[NF - 1], C0)); GAPM(C1 = MF32(kf[2 * NF - 1], qr[NF - 1], C1)); } \
    l_reg += sacc; \
    if (GK) { DMA_K((t) + 3, ks_cur); } if (GV) { DMA_V((t) + 1, vs_next); } \
    NAMASK(C0, C1, t); \
    SBAR(); \
    GAPB(o[0] = MF32(PAF(0), VFR(0), o[0]), C0, 0); \
    GAPB(o[1] = MF32(PAF(0), VFR(4), o[1]), C0, 4); \
    KRD(GL, 0); GAPB(o[0] = MF32(PAF(1), VFR(1), o[0]), C0, 8); \
    KRD(GL, 1); GAPB(o[1] = MF32(PAF(1), VFR(5), o[1]), C0, 12); \
    KRD(GL, 2); GAPB(o[0] = MF32(PAF(2), VFR(2), o[0]), C1, 0); \
    KRD(GL, 3); GAPB(o[1] = MF32(PAF(2), VFR(6), o[1]), C1, 4); \
    if constexpr (NF == 6) { KRD(GL, NF - 2); } GAPB(o[0] = MF32(PAF(3), VFR(3), o[0]), C1, 8); \
    if constexpr (NF == 6) { KRD(GL, NF - 1); } GAPB(o[1] = MF32(PAF(3), VFR(7), o[1]), C1, 12); \
    } while (0)
    int t = 1;
    for (; t + 5 < NT; t += 2) {
        STEP(pB0, pB1, pA0, pA1, t, true, true, true);     WAIT_BAR2(3, 2); RESC(); ROT();
        STEP(pA0, pA1, pB0, pB1, t + 1, true, true, true); WAIT_BAR2(3, 2); RESC(); ROT();
    }
#define ENDW(tt) do { if ((tt) + 3 < NT) { WAIT_BAR2(3, 2); } else if ((tt) + 2 < NT) { WAIT_BAR2(1, 1); } else { WAIT_BAR2(0, 0); } } while (0)
    for (; t + 1 < NT; t += 2) {
        STEP(pB0, pB1, pA0, pA1, t, (t + 3 < NT), (t + 1 < NT), (t + 1 < NT));         ENDW(t);     RESC(); ROT();
        STEP(pA0, pA1, pB0, pB1, t + 1, (t + 4 < NT), (t + 2 < NT), (t + 2 < NT));     ENDW(t + 1); RESC(); ROT();
    }
    STEP(pB0, pB1, pA0, pA1, NT - 1, false, false, false); RESC();
    { float sacc = pB0[0] + pB0[1];
#pragma unroll
      for (int r = 2; r < 16; ++r) sacc += pB0[r];
#pragma unroll
      for (int r = 0; r < 16; ++r) sacc += pB1[r];
      l_reg += sacc;
      pw0 = (u32x4){PKW(pB0, 0), PKW(pB0, 2), PKW(pB0, 4), PKW(pB0, 6)}; pw1 = (u32x4){PKW(pB0, 8), PKW(pB0, 10), PKW(pB0, 12), PKW(pB0, 14)};
      pw2 = (u32x4){PKW(pB1, 0), PKW(pB1, 2), PKW(pB1, 4), PKW(pB1, 6)}; pw3 = (u32x4){PKW(pB1, 8), PKW(pB1, 10), PKW(pB1, 12), PKW(pB1, 14)};
      SBAR(); pv(o, vb0 + vs_cur, PAF(0), PAF(1), PAF(2), PAF(3)); }
    { auto rr = __builtin_amdgcn_permlane32_swap(__float_as_uint(l_reg), __float_as_uint(l_reg), false, false); l_reg = __uint_as_float(rr[0]) + __uint_as_float(rr[1]); }
    if (hi == 0) wsf[32 + r32] = l_reg; asm volatile("s_waitcnt lgkmcnt(0)" ::: "memory");
    float rli[16];
#pragma unroll
    for (int r = 0; r < 16; ++r) rli[r] = __builtin_amdgcn_rcpf(wsf[32 + crow(r, hi)]);
    bf16* Ow = Ow0 + (size_t)(wid * QBLK) * LDO;
    { LAS bf16* stg = (LAS bf16*)(shm + LDS_OST) + wid * 2048;
#pragma unroll
      for (int r = 0; r < 16; ++r) { const int orow = crow(r, hi);
#pragma unroll
        for (int d0 = 0; d0 < 2; ++d0) stg[orow * 64 + d0 * 32 + r32] = (bf16)(cvtpk(o[d0][r] * rli[r], 0.f) & 0xffffu); }
      asm volatile("s_waitcnt lgkmcnt(0)" ::: "memory");
#pragma unroll
      for (int i = 0; i < 4; ++i) { const int row = i * 8 + (lane >> 3), ch = lane & 7; const u32x4 v = *(const LAS u32x4*)(stg + row * 64 + ch * 8); *(u32x4*)(Ow + (size_t)row * LDO + ch * 8) = v; } }
    asm volatile("s_waitcnt lgkmcnt(0)\n\ts_barrier" ::: "memory");
#undef DMA_K
#undef DMA_V
#undef START
#undef RESC
#undef ROT
#undef PKW
#undef PAF
#undef VFR
#undef PIN
#undef MX3
#undef GAPA
#undef GAPM
#undef GAPB
#undef EX
#undef VRD
#undef KRD
#undef MF32
#undef NAMASK
#undef TROW
#undef STEP
#undef ENDW
}
#undef SBAR
#undef WAIT_BAR2
}

#define XB_TMO      128
#define XB_XCNT(j)  (256  + 64 * (j))
#define XB_XSUB(j)  (1280 + 64 * (j))
#define XB_XGEN(j)  (2304 + 64 * (j))
#define XB_TOP      3328
#define XB_TOPGEN   3392
#define XCD_BAR_WORDS 3456
#define XB_SPIN_CAP (1u << 22)
__device__ __forceinline__ unsigned xb_ld(unsigned* p)              { return __hip_atomic_load(p, __ATOMIC_RELAXED, __HIP_MEMORY_SCOPE_AGENT); }
__device__ __forceinline__ unsigned xb_add(unsigned* p, unsigned v) { return __hip_atomic_fetch_add(p, v, __ATOMIC_RELAXED, __HIP_MEMORY_SCOPE_AGENT); }
__device__ __forceinline__ unsigned xb_xcc_id() { return (unsigned)__builtin_amdgcn_s_getreg((3 << 11) | 20) & 0xFu; }
#define XB_SPIN(cond, bar) do { unsigned _sp = 0; while (cond) { __builtin_amdgcn_s_sleep(1); \
    if ((++_sp & 255u) == 0u) { if (xb_ld(&(bar)[XB_TMO])) break; if (_sp > XB_SPIN_CAP) { atomicAdd(&(bar)[XB_TMO], 1u); break; } } } } while (0)
struct XcdBarrier { unsigned* bar; unsigned x; volatile LAS unsigned* st; };
__device__ __forceinline__ XcdBarrier xcd_barrier_post(unsigned* bar, volatile LAS unsigned* st) {
    XcdBarrier b; b.bar = bar; b.x = xb_xcc_id(); b.st = st;
    if (threadIdx.x == 0) (void)xb_add(&bar[XB_XCNT(b.x)], 1u);
    return b;
}
__device__ __forceinline__ void xcd_barrier_complete(unsigned* bar, unsigned x, unsigned& nloc, unsigned& nx) {
    const unsigned G = gridDim.x * gridDim.y * gridDim.z;
    unsigned sum, cnt, mine, sp = 0u;
    for (;;) {
        sum = 0u; cnt = 0u; mine = 0u;
#pragma unroll
        for (unsigned j = 0; j < 16; ++j) { const unsigned c = xb_ld(&bar[XB_XCNT(j)]); sum += c; cnt += (c > 0u) ? 1u : 0u; mine = (j == x) ? c : mine; }
        if (sum == G) break;
        __builtin_amdgcn_s_sleep(1);
        if ((++sp & 255u) == 0u) { if (xb_ld(&bar[XB_TMO])) break; if (sp > XB_SPIN_CAP) { atomicAdd(&bar[XB_TMO], 1u); break; } }
    }
    nloc = mine > 0u ? mine : 1u; nx = cnt > 0u ? cnt : 1u;
}
__device__ __forceinline__ void xcd_barrier(const XcdBarrier& b) {
    asm volatile("s_waitcnt vmcnt(0)" ::: "memory");
    __syncthreads();
    int tid0_ = threadIdx.x; asm volatile("" : "+v"(tid0_));
    if (tid0_ == 0) {
        unsigned* bar = b.bar;
        __builtin_amdgcn_s_waitcnt(0);
        unsigned nloc = b.st[0], nx = b.st[1];
        if (nloc == 0u) { xcd_barrier_complete(bar, b.x, nloc, nx); b.st[0] = nloc; b.st[1] = nx; }
        const unsigned old = xb_add(&bar[XB_XSUB(b.x)], 1u);
        const unsigned gen = old / nloc;
        if (old + 1u == (gen + 1u) * nloc) {
            __builtin_amdgcn_fence(__ATOMIC_RELEASE, "agent");
            asm volatile("s_waitcnt vmcnt(0)" ::: "memory");
            const unsigned og = xb_add(&bar[XB_TOP], 1u);
            const unsigned tg = og / nx;
            if (og + 1u == (tg + 1u) * nx) xb_add(&bar[XB_TOPGEN], 1u);
            else XB_SPIN(xb_ld(&bar[XB_TOPGEN]) == tg, bar);
            __builtin_amdgcn_fence(__ATOMIC_ACQUIRE, "agent");
            xb_add(&bar[XB_XGEN(b.x)], 1u);
            asm volatile("s_waitcnt vmcnt(0)" ::: "memory");
        } else {
            XB_SPIN(xb_ld(&bar[XB_XGEN(b.x)]) == gen, bar);
            __builtin_amdgcn_fence(__ATOMIC_ACQUIRE, "agent");
            asm volatile("s_waitcnt vmcnt(0)" ::: "memory");
        }
    }
    __syncthreads();
}

constexpr int NWAVES = 8, NTHREADS = 512;
constexpr int RING_OFF = 0, RING_BYTES = 131072, LDSCTL_OFF = RING_BYTES, MISC_OFF = LDSCTL_OFF + 320, LDS_BYTES = 147456;
static_assert(mla::Lay<96>::LDS_BYTES <= RING_BYTES && mla::Lay<64>::LDS_BYTES <= RING_BYTES, "attention LDS");

struct Args { const float* in[26]; float* out; unsigned char* ws; int ph_lo, ph_hi; };
enum { I_X = 0, I_C, I_CTX, I_CCTX, I_MODW, I_MODB, I_LN1G, I_LN1B, I_LN2G, I_LN2B, I_WIN, I_RELB, I_QNORM, I_WQUP, I_KVNORM, I_WKVUP, I_WOUT, I_FG, I_FU, I_FD, I_POOLW, I_POOLS, I_ROUTER, I_MG, I_MU, I_MD };

struct Frame {
    LAS unsigned char* lds; int tid, lane, wave, vcu, G; unsigned char* ws; const float* const* in; float* out;
};
__device__ __forceinline__ const float* modv(const Frame& F, int layer, int s, int part) { return (const float*)(F.ws + WS_MODV) + ((size_t)(layer * 2 + s) * 6 + part) * D; }

__device__ __forceinline__ float kmax_q(const float* tab, int q, int lane) {
    const float* t = tab + q * 130; float m = fmaxf(t[lane], t[64 + lane]); if (lane < 2) m = fmaxf(m, t[128 + lane]);
#pragma unroll
    for (int o = 1; o < 64; o <<= 1) m = fmaxf(m, __shfl_xor(m, o));
    return m;
}
__device__ __forceinline__ int gu_row(int n0) { return (n0 >> 7) * 256 + (n0 & 127); }
constexpr int MOE_WE = 168, MOE_W = 8 * MOE_WE;
__device__ __forceinline__ unsigned pack4i8(float a, float b, float c, float d) {
    const int ia = (int)__builtin_rintf(a), ib = (int)__builtin_rintf(b), ic = (int)__builtin_rintf(c), id = (int)__builtin_rintf(d);
    return (unsigned)(ia & 255) | ((unsigned)(ib & 255) << 8) | ((unsigned)(ic & 255) << 16) | ((unsigned)id << 24);
}
__device__ __forceinline__ void conv_i8_strip(Frame& F, const float* W, int ldw, int n0, unsigned char* out8, int orow0, float* wsc, int nvalid = 64, float cs = 1.f) {
    LAS float* part = (LAS float*)(F.lds + RING_OFF + 12288);
    const bool live = F.lane < nvalid;
    const float* src = W + (size_t)(128 * F.wave) * ldw + n0 + (live ? F.lane : 0);
    const float csl = live ? cs : 0.f;
    float v[128]; float cm = 0.f;
#pragma unroll
    for (int i = 0; i < 128; ++i) v[i] = src[(size_t)i * ldw] * csl;
#pragma unroll
    for (int i = 0; i < 128; ++i) cm = fmaxf(cm, fabsf(v[i]));
#pragma unroll
    for (int o = 1; o < 64; o <<= 1) cm = fmaxf(cm, __shfl_xor(cm, o));
    part[F.wave * 64 + F.lane] = cm;
    __syncthreads();
#pragma unroll
    for (int w = 0; w < 8; ++w) cm = fmaxf(cm, part[w * 64 + F.lane]);
    const float sc = cm > 0.f ? 127.f / cm : 0.f;
    if (F.wave == 0) wsc[orow0 + F.lane] = cm * (1.f / 127.f);
    unsigned char* dst = out8 + (size_t)(orow0 + F.lane) * 1024 + 128 * F.wave;
#pragma unroll
    for (int g = 0; g < 8; ++g) { u32x4 o;
        o.x = pack4i8(v[16 * g] * sc, v[16 * g + 1] * sc, v[16 * g + 2] * sc, v[16 * g + 3] * sc); o.y = pack4i8(v[16 * g + 4] * sc, v[16 * g + 5] * sc, v[16 * g + 6] * sc, v[16 * g + 7] * sc);
        o.z = pack4i8(v[16 * g + 8] * sc, v[16 * g + 9] * sc, v[16 * g + 10] * sc, v[16 * g + 11] * sc); o.w = pack4i8(v[16 * g + 12] * sc, v[16 * g + 13] * sc, v[16 * g + 14] * sc, v[16 * g + 15] * sc);
        *(u32x4*)(dst + 16 * g) = o; }
    __syncthreads();
}
template <bool FP8>
__device__ __forceinline__ void conv_strip(const float* W, int ldw, int k0, int n0, void* out, int ldt, int orow0, int ocol0, const float* ks, const float* ns, float cs, int lane) {
    const float* src = W + (size_t)k0 * ldw + n0 + lane; const float nsv = (ns ? ns[n0 + lane] : 1.f) * cs;
    float v[128];
#pragma unroll
    for (int i = 0; i < 128; ++i) v[i] = src[(size_t)i * ldw] * nsv;
    if (ks) {
#pragma unroll
        for (int i = 0; i < 128; ++i) v[i] *= ks[k0 + i]; }
    if constexpr (FP8) { unsigned char* dst = (unsigned char*)out + (size_t)(orow0 + lane) * ldt + ocol0 + k0;
#pragma unroll
        for (int g = 0; g < 8; ++g) { int w[4];
#pragma unroll
            for (int q = 0; q < 4; ++q) { int t = 0; t = __builtin_amdgcn_cvt_pk_fp8_f32(v[16 * g + 4 * q], v[16 * g + 4 * q + 1], t, false); t = __builtin_amdgcn_cvt_pk_fp8_f32(v[16 * g + 4 * q + 2], v[16 * g + 4 * q + 3], t, true); w[q] = t; }
            *(u32x4*)(dst + 16 * g) = (u32x4){(unsigned)w[0], (unsigned)w[1], (unsigned)w[2], (unsigned)w[3]}; }
    } else { bf16* dst = (bf16*)out + (size_t)(orow0 + lane) * ldt + ocol0 + k0;
#pragma unroll
        for (int g = 0; g < 16; ++g) *(u32x4*)(dst + 8 * g) = (u32x4){cvtpk(v[8 * g], v[8 * g + 1]), cvtpk(v[8 * g + 2], v[8 * g + 3]), cvtpk(v[8 * g + 4], v[8 * g + 5]), cvtpk(v[8 * g + 6], v[8 * g + 7])}; }
}
constexpr int D_WQU = 24, D_WKV = 16, D_WOUT = 128, D_WDN = 352, D_POOL = 32, D_ALL = D_WQU + D_WKV + D_WOUT + D_WDN + D_POOL;
__device__ __forceinline__ void conv_dense_item(Frame& F, int j, int r) {
    if (r < D_WQU) { const int sb = r / 2, kb = r % 2; conv_strip<false>(F.in[I_WQUP] + (size_t)j * 256 * 768, 768, 128 * kb, 64 * sb, F.ws + WS_WUP + (size_t)j * 3 * MiB / 2, UP_K, 64 * sb, 0, F.in[I_QNORM] + j * 256, nullptr, QS_MLA, F.lane); return; } r -= D_WQU;
    if (r < D_WKV) { conv_strip<false>(F.in[I_WKVUP] + (size_t)j * 128 * 1024, 1024, 0, 64 * r, F.ws + WS_WUP + (size_t)j * 3 * MiB / 2, UP_K, 768 + 64 * r, 256, F.in[I_KVNORM] + j * 128, nullptr, 1.f, F.lane); return; } r -= D_WKV;
    if (r < D_WOUT) { const int sb = r / 8, kb = r % 8; conv_strip<false>(F.in[I_WOUT] + (size_t)j * D * D, D, 128 * kb, 64 * sb, F.ws + WS_WOUT + (size_t)j * D * D * 2, D, 64 * sb, 0, nullptr, nullptr, 1.f, F.lane); return; } r -= D_WOUT;
    if (r < D_WDN) { const int sb = r / 22, kb = r % 22; conv_strip<true>(F.in[I_FD] + (size_t)j * FFN * D, D, 128 * kb, 64 * sb, F.ws + WS_WDN + (size_t)j * 11 * MiB / 2, FFN, 64 * sb, 0, nullptr, nullptr, W8_SCALE, F.lane); return; } r -= D_WDN;
    { const int g = r / 8, q = r % 8, sb = q / 2, kb = q % 2; conv_strip<false>(F.in[I_POOLW] + (size_t)(j * 4 + g) * 65536, 256, 128 * kb, 64 * sb, F.ws + WS_WPOOL + (size_t)(j * 4 + g) * 65536 * 2, 256, 64 * sb, 0, nullptr, F.in[I_POOLS] + j * D + g * 256, 1.f, F.lane); }
}
__device__ __forceinline__ void conv_moedown_item(Frame& F, int j, int e, int q) {
    const int sb = q / 28, kb = q % 28;
    conv_strip<true>(F.in[I_MD] + (size_t)(j * 8 + e) * EDIM * D, D, 128 * kb, 64 * sb, F.ws + WS_MDN + (size_t)(j * 8 + e) * 7 * MiB, EDIM, 64 * sb, 0, nullptr, nullptr, W8_SCALE, F.lane);
}
__device__ __forceinline__ void moe_work(Frame& F, int j, int w) {
    const int e = w / MOE_WE, r = w % MOE_WE;
    if (r < 112) { const int up = r / 56, n0 = 64 * (r % 56);
        conv_i8_strip(F, F.in[up ? I_MU : I_MG] + (size_t)(j * 8 + e) * D * EDIM, EDIM, n0, F.ws + WS_MGU + (size_t)(j * 8 + e) * 7 * MiB, gu_row(n0) + up * 128, (float*)(F.ws + WS_WSCM) + (size_t)(j * 8 + e) * 7168);
    } else { const int c = r - 112; conv_moedown_item(F, j, e, c * 8 + F.wave); }
}
__device__ __forceinline__ void p0_prologue(Frame& F0) {
    Frame F = F0; { int t = threadIdx.x; asm volatile("" : "+v"(t)); F.tid = t; F.lane = t & 63; F.wave = __builtin_amdgcn_readfirstlane(t >> 6); }
    LAS float* scr = (LAS float*)(F.lds + RING_OFF + F.wave * 16384);
    const int gw = F.vcu * NWAVES + F.wave, NGW = F.G * NWAVES;
    {
        LAS float* sl = (LAS float*)(F.lds + 65536);
        LAS float* part = (LAS float*)(F.lds + 65536 + 8192);
        for (int it = blockIdx.x; it < 4 * 48; it += F.G) {
            const int layer = it / 48, ch = it % 48;
            for (int k = F.tid; k < 2048; k += NTHREADS) { const float v = (k < 1024) ? F.in[I_C][k] : F.in[I_CCTX][k - 1024]; sl[k] = v / (1.f + __expf(-v)); }
            __syncthreads();
            const float* W = F.in[I_MODW] + (size_t)layer * D * 6 * D + ch * 128 + 2 * F.lane;
            float a0 = 0.f, a1 = 0.f, b0 = 0.f, b1 = 0.f;
#pragma unroll 32
            for (int kk = 0; kk < 128; ++kk) { const int k = F.wave * 128 + kk; const f32x2 w = *(const f32x2*)(W + (size_t)k * 6 * D); const float sa = sl[k], sb = sl[1024 + k];
                a0 += sa * w[0]; a1 += sa * w[1]; b0 += sb * w[0]; b1 += sb * w[1]; }
            part[(F.wave * 2 + 0) * 128 + 2 * F.lane] = a0; part[(F.wave * 2 + 0) * 128 + 2 * F.lane + 1] = a1;
            part[(F.wave * 2 + 1) * 128 + 2 * F.lane] = b0; part[(F.wave * 2 + 1) * 128 + 2 * F.lane + 1] = b1;
            __syncthreads();
            if (F.tid < 256) { const int s = F.tid >> 7, cidx = F.tid & 127; float v = F.in[I_MODB][(size_t)layer * 6 * D + ch * 128 + cidx];
#pragma unroll
                for (int w = 0; w < 8; ++w) v += part[(w * 2 + s) * 128 + cidx];
                ((float*)(F.ws + WS_MODV))[(size_t)(layer * 2 + s) * 6 * D + ch * 128 + cidx] = v; }
            __syncthreads();
        }
    }
    if (blockIdx.x == F.G - 1) for (int i = F.tid; i < 2048; i += NTHREADS) { const int pos = i >> 3, f = i & 7; const double inv = exp(-log(10000.0) * (double)f / 8.0), ang = (double)pos * inv;
        float* t = (float*)(F.ws + WS_ROPE) + pos * 16; t[f] = (float)cos(ang); t[8 + f] = (float)sin(ang); }
    {
        const int gt = F.vcu * NTHREADS + F.tid, NGT = F.G * NTHREADS; const u32x4 z = {0u, 0u, 0u, 0u};
        constexpr int NZ_WIN = 64 * 64, NZ_A = 768 * 16, NZ_B = 1024 * 32, NZ = NZ_WIN + NZ_A + NZ_B;
        for (int i = gt; i < 2 * NZ; i += NGT) { const int j = i / NZ; int r = i % NZ;
            unsigned char* win = F.ws + WS_WIN + (size_t)j * 2048 * 1024; bf16* wup = (bf16*)(F.ws + WS_WUP + (size_t)j * 3 * MiB / 2);
            if (r < NZ_WIN) { *(u32x4*)(win + (size_t)(1984 + r / 64) * 1024 + (r % 64) * 16) = z; if (r < 64) ((float*)(F.ws + WS_WSCI))[j * 2048 + 1984 + r] = 0.f; continue; } r -= NZ_WIN;
            if (r < NZ_A) { *(u32x4*)(wup + (size_t)(r / 16) * UP_K + 256 + (r % 16) * 8) = z; continue; } r -= NZ_A;
            *(u32x4*)(wup + (size_t)(768 + r / 32) * UP_K + (r % 32) * 8) = z; }
    }
    { const int n0w = MOE_W, n1w = MOE_W;
      for (int it = (F.G >= 62) ? ((int)blockIdx.x >= F.G - 62 ? (int)blockIdx.x - (F.G - 62) : 62) : (int)blockIdx.x; it < 62; it += F.G) { const int j = it / 31, n0 = 64 * (it % 31);
          conv_i8_strip(F, F.in[I_WIN] + (size_t)j * D * IN_COLS, IN_COLS, n0, F.ws + WS_WIN + (size_t)j * 2048 * 1024, n0, (float*)(F.ws + WS_WSCI) + j * 2048, n0 + 64 <= IN_COLS ? 64 : IN_COLS - n0, n0 < 512 ? QS_NA : 1.f); }
      for (int it = blockIdx.x; it < 176 + n0w + n1w; it += F.G) {
        if (it < 176) { const int j = it / 88, q = it % 88, up = q / 44, n0 = 64 * (q % 44);
            conv_i8_strip(F, F.in[up ? I_FU : I_FG] + (size_t)j * D * FFN, FFN, n0, F.ws + WS_WGU + (size_t)j * 5632 * 1024, gu_row(n0) + up * 128, (float*)(F.ws + WS_WSC) + j * 5632); }
        else if (it - 176 < n0w) moe_work(F, 0, (MOE_W - n0w) + (it - 176));
        else moe_work(F, 1, (MOE_W - n1w) + (it - 176 - n0w)); } }
    for (int it = F.wave * F.G + F.vcu; it < 2 * D_ALL; it += NGW) conv_dense_item(F, it / D_ALL, it % D_ALL);
}

__device__ __forceinline__ void ld16(const float* p, int lane, float (&v)[16]) {
#pragma unroll
    for (int j = 0; j < 4; ++j) { const f32x4 t = *(const f32x4*)(p + 256 * j + 4 * lane); v[4 * j] = t[0]; v[4 * j + 1] = t[1]; v[4 * j + 2] = t[2]; v[4 * j + 3] = t[3]; }
}
__device__ __forceinline__ void st16(float* p, int lane, const float (&v)[16]) {
#pragma unroll
    for (int j = 0; j < 4; ++j) *(f32x4*)(p + 256 * j + 4 * lane) = (f32x4){v[4 * j], v[4 * j + 1], v[4 * j + 2], v[4 * j + 3]};
}
__device__ __forceinline__ void st16bf(bf16* p, int lane, const float (&v)[16]) {
#pragma unroll
    for (int j = 0; j < 4; ++j) *(u32x2*)(p + 256 * j + 4 * lane) = (u32x2){cvtpk(v[4 * j], v[4 * j + 1]), cvtpk(v[4 * j + 2], v[4 * j + 3])};
}
__device__ __forceinline__ void addbf16(const bf16* p, int lane, float (&v)[16]) {
#pragma unroll
    for (int j = 0; j < 4; ++j) { const u32x2 w = *(const u32x2*)(p + 256 * j + 4 * lane); v[4 * j] += bf_lo(w.x); v[4 * j + 1] += bf_hi(w.x); v[4 * j + 2] += bf_lo(w.y); v[4 * j + 3] += bf_hi(w.y); }
}
struct RowPass {
    const float* src_lat; const float* src_ctx;
    float* dst_lat; float* dst_ctx;
    bool do_ctx;
    bool skip_lat_store;
    const float* ln_g; const float* ln_b;
    const float* sh_lat; const float* sc_lat; const float* sh_ctx; const float* sc_ctx;
    bool write_h; bool h8; bool hi8; float* hsc; bf16* H;
    const float* g2_lat; const float* g2_ctx; const bf16* OUTm; const bf16* OUTm2; const int* rowslot; const unsigned* cnt;
    const float* router; int* rowslot_w; int* listTok; float* listW; unsigned* cnt_w;
};
template <bool DO_LN, bool MOE_IN, bool ROUTE>
__device__ __forceinline__ void row_pass(Frame& F0, const RowPass& P) {
    Frame F = F0; { int t = threadIdx.x; asm volatile("" : "+v"(t)); F.tid = t; F.lane = t & 63; F.wave = __builtin_amdgcn_readfirstlane(t >> 6); }
    LAS float* rt = (LAS float*)(F.lds);
    LAS int* selE = (LAS int*)(F.lds + 32768);
    LAS float* selW = (LAS float*)(F.lds + 32768 + 1024);
    LAS int* selR = (LAS int*)(F.lds + 32768 + 2048);
    int nsel = 0;
    if (ROUTE) { for (int i = F.tid; i < 8192; i += NTHREADS) rt[(i & 7) * 1024 + (i >> 3)] = P.router[i]; __syncthreads(); }
    int pb[8];
    if (MOE_IN) { int p = 0;
#pragma unroll
        for (int e = 0; e < 8; ++e) { const int n = (int)__hip_atomic_load(P.cnt + 64 * e, __ATOMIC_RELAXED, __HIP_MEMORY_SCOPE_AGENT); pb[e] = p; p += (n + 255) >> 8; } }
    float lg[16], lb[16];
    if (DO_LN) { ld16(P.ln_g, F.lane, lg); ld16(P.ln_b, F.lane, lb); }
    for (int s = P.do_ctx ? 0 : 1; s < 2; ++s) {
        const int n = s ? NLAT : NCTX, per = (n + F.G - 1) / F.G, r_lo = F.vcu * per, r_hi = min(r_lo + per, n);
        const float* src = s ? P.src_lat : P.src_ctx; float* dst = s ? P.dst_lat : P.dst_ctx;
        float sh[16], sc[16], g2[16];
        if (P.write_h) { ld16(s ? P.sh_lat : P.sh_ctx, F.lane, sh); ld16(s ? P.sc_lat : P.sc_ctx, F.lane, sc); }
        if (MOE_IN) ld16(s ? P.g2_lat : P.g2_ctx, F.lane, g2);
        for (int r = r_lo + F.wave; r < r_hi; r += NWAVES) {
            const int grow = s ? NCTX + r : r;
            float v[16]; ld16(src + (size_t)r * D, F.lane, v);
            if (MOE_IN) {
                const int e1 = P.rowslot[grow * 4 + 0], p1 = P.rowslot[grow * 4 + 1], e2 = P.rowslot[grow * 4 + 2], p2 = P.rowslot[grow * 4 + 3];
                int b1 = 0, b2 = 0;
#pragma unroll
                for (int e = 0; e < 8; ++e) { if (e1 == e) b1 = pb[e]; if (e2 == e) b2 = pb[e]; }
                float y[16];
#pragma unroll
                for (int i = 0; i < 16; ++i) y[i] = 0.f;
                addbf16(P.OUTm + (size_t)(b1 * 256 + p1) * D, F.lane, y); addbf16(P.OUTm + (size_t)(b2 * 256 + p2) * D, F.lane, y);
                addbf16(P.OUTm2 + (size_t)(b1 * 256 + p1) * D, F.lane, y); addbf16(P.OUTm2 + (size_t)(b2 * 256 + p2) * D, F.lane, y);
#pragma unroll
                for (int i = 0; i < 16; ++i) v[i] = v[i] * ALPHA + g2[i] * y[i];
            }
            if (DO_LN) {
                float sm = 0.f;
#pragma unroll
                for (int i = 0; i < 16; ++i) sm += v[i];
                const float mean = wave_sum(sm) * (1.f / D); float s2 = 0.f;
#pragma unroll
                for (int i = 0; i < 16; ++i) { v[i] -= mean; s2 += v[i] * v[i]; }
                const float rstd = rsqrtf(wave_sum(s2) * (1.f / D) + LN_EPS);
#pragma unroll
                for (int i = 0; i < 16; ++i) v[i] = v[i] * rstd * lg[i] + lb[i];
            }
            if (!(P.skip_lat_store && s == 1)) st16(dst + (size_t)r * D, F.lane, v);
            if (P.write_h) {
#pragma unroll
                for (int i = 0; i < 16; ++i) v[i] = v[i] * (1.f + sc[i]) + sh[i];
                if (P.hi8) { float am = 0.f;
#pragma unroll
                    for (int i = 0; i < 16; ++i) am = fmaxf(am, fabsf(v[i]));
#pragma unroll
                    for (int o = 1; o < 64; o <<= 1) am = fmaxf(am, __shfl_xor(am, o));
                    const float qs = am > 0.f ? 127.f / am : 0.f;
                    if (F.lane == 0) P.hsc[grow] = am * (1.f / 127.f);
#pragma unroll
                    for (int jj = 0; jj < 4; ++jj) *(unsigned*)((unsigned char*)P.H + (size_t)grow * D + 256 * jj + 4 * F.lane) = pack4i8(v[4 * jj] * qs, v[4 * jj + 1] * qs, v[4 * jj + 2] * qs, v[4 * jj + 3] * qs);
                } else if (P.h8) {
#pragma unroll
                    for (int jj = 0; jj < 4; ++jj) { int w = 0; w = __builtin_amdgcn_cvt_pk_fp8_f32(v[4 * jj], v[4 * jj + 1], w, false); w = __builtin_amdgcn_cvt_pk_fp8_f32(v[4 * jj + 2], v[4 * jj + 3], w, true);
                        *(int*)((unsigned char*)P.H + (size_t)grow * D + 256 * jj + 4 * F.lane) = w; }
                } else st16bf(P.H + (size_t)grow * D, F.lane, v);
                if (ROUTE) {
                    float lgt[8];
#pragma unroll
                    for (int e = 0; e < 8; ++e) { float a = 0.f;
#pragma unroll
                        for (int j = 0; j < 4; ++j) { const f32x4 w = *(const LAS f32x4*)(rt + e * 1024 + 256 * j + 4 * F.lane); a += v[4 * j] * w[0] + v[4 * j + 1] * w[1] + v[4 * j + 2] * w[2] + v[4 * j + 3] * w[3]; }
                        lgt[e] = wave_sum(a); }
                    int e1 = 0; float v1 = lgt[0];
#pragma unroll
                    for (int e = 1; e < 8; ++e) if (lgt[e] > v1) { v1 = lgt[e]; e1 = e; }
                    int e2 = -1; float v2 = -INFINITY;
#pragma unroll
                    for (int e = 0; e < 8; ++e) if (e != e1 && lgt[e] > v2) { v2 = lgt[e]; e2 = e; }
                    const float w1 = 1.f / (1.f + __expf(v2 - v1)), w2 = 1.f - w1;
                    const int slot = F.wave + 8 * nsel; ++nsel;
                    if (F.lane == 0) { selE[slot * 2] = e1; selE[slot * 2 + 1] = e2; selW[slot * 2] = w1; selW[slot * 2 + 1] = w2; selR[slot] = grow; }
                }
            }
        }
    }
    if (ROUTE) {
        LAS int* nselL = (LAS int*)(F.lds + 32768 + 3072);
        if (F.lane == 0) nselL[F.wave] = nsel;
        __syncthreads();
        if (F.tid < 8) { const int e = F.tid; int c = 0;
            for (int w = 0; w < 8; ++w) for (int k = 0; k < nselL[w]; ++k) { const int sl = w + 8 * k; c += (selE[sl * 2] == e) + (selE[sl * 2 + 1] == e); }
            int base = (int)__hip_atomic_fetch_add(P.cnt_w + 64 * e, (unsigned)c, __ATOMIC_RELAXED, __HIP_MEMORY_SCOPE_AGENT);
            for (int w = 0; w < 8; ++w) for (int k = 0; k < nselL[w]; ++k) { const int sl = w + 8 * k; const int grow = selR[sl];
                if (selE[sl * 2] == e) { P.listTok[(size_t)e * NTOK + base] = grow; P.listW[(size_t)e * NTOK + base] = selW[sl * 2]; P.rowslot_w[grow * 4 + 0] = e; P.rowslot_w[grow * 4 + 1] = base; ++base; }
                if (selE[sl * 2 + 1] == e) { P.listTok[(size_t)e * NTOK + base] = grow; P.listW[(size_t)e * NTOK + base] = selW[sl * 2 + 1]; P.rowslot_w[grow * 4 + 2] = e; P.rowslot_w[grow * 4 + 3] = base; ++base; } }
        }
        __syncthreads();
    }
}

template <bool FP8, int K>
__device__ __forceinline__ void ctx_gemm_resid(Frame& F0, const void* A_, int lda, int acs, const void* Bt_, int ldb, float* Xc, const float* gate, float sc = 1.f) {
    Frame F = F0; { int t = threadIdx.x; asm volatile("" : "+v"(t)); F.tid = t; F.lane = t & 63; F.wave = __builtin_amdgcn_readfirstlane(t >> 6); }
    LAS float* red = (LAS float*)(F.lds + RING_OFF);
    const int r32 = F.lane & 31, hi = F.lane >> 5;
    for (int tile = F.vcu; tile < 256; tile += F.G) {
        const int rb = tile >> 5, cb = tile & 31, row0 = 32 * rb, col0 = 32 * cb;
        f32x16 acc = {};
        constexpr int nsteps = K / 128;
        if constexpr (FP8) {
            const unsigned char* ap = (const unsigned char*)A_ + (size_t)(row0 + r32) * lda + ((col0 >> 8) * acs) + 8 * hi + (F.wave * nsteps) * 16;
            const unsigned char* bp = (const unsigned char*)Bt_ + (size_t)(col0 + r32) * ldb + 8 * hi + (F.wave * nsteps) * 16;
            long av[nsteps], bv[nsteps];
#pragma unroll
            for (int i = 0; i < nsteps; ++i) { av[i] = *(const long*)(ap + i * 16); bv[i] = *(const long*)(bp + i * 16); }
#pragma unroll
            for (int i = 0; i < nsteps; ++i) acc = __builtin_amdgcn_mfma_f32_32x32x16_fp8_fp8(av[i], bv[i], acc, 0, 0, 0);
        } else {
            const bf16* ap = (const bf16*)A_ + (size_t)(row0 + r32) * lda + ((col0 >> 8) * acs) + 8 * hi + (F.wave * nsteps) * 16;
            const bf16* bp = (const bf16*)Bt_ + (size_t)(col0 + r32) * ldb + 8 * hi + (F.wave * nsteps) * 16;
            bf16x8 av[nsteps], bv[nsteps];
#pragma unroll
            for (int i = 0; i < nsteps; ++i) { av[i] = *(const bf16x8*)(ap + i * 16); bv[i] = *(const bf16x8*)(bp + i * 16); }
#pragma unroll
            for (int i = 0; i < nsteps; ++i) acc = __builtin_amdgcn_mfma_f32_32x32x16_bf16(av[i], bv[i], acc, 0, 0, 0);
        }
#pragma unroll
        for (int r = 0; r < 16; ++r) red[(F.wave * 16 + r) * 64 + F.lane] = acc[r];
        __syncthreads();
#pragma unroll
        for (int q = 0; q < 2; ++q) { const int o = F.tid + 512 * q, m = o >> 5, n = o & 31;
            const int h = (m >> 2) & 1, rg = (m & 3) + 4 * (m >> 3); float sum = 0.f;
#pragma unroll
            for (int w = 0; w < 8; ++w) sum += red[(w * 16 + rg) * 64 + n + 32 * h];
            float* xp = Xc + (size_t)(row0 + m) * D + col0 + n; *xp = *xp * ALPHA + gate[col0 + n] * (sum * sc); }
        __syncthreads();
    }
}
__device__ __forceinline__ void pool_pass(Frame& F0, const float* Xl, const float* Xc, bool do_ctx, const float* sc_lat, const float* sc_ctx, bf16* PM) {
    Frame F = F0; { int t = threadIdx.x; asm volatile("" : "+v"(t)); F.tid = t; F.lane = t & 63; F.wave = __builtin_amdgcn_readfirstlane(t >> 6); }
    const int hw = F.vcu * 2 + (F.tid >> 8), NHW = F.G * 2, c4 = (F.tid & 255) * 4, half = 1 << (c4 >> 8);
    const int nstrips = 512 + (do_ctx ? 32 : 0);
    for (int st = hw; st < nstrips; st += NHW) {
        const bool isl = st < 512; const int n = isl ? NLAT : NCTX, t0 = isl ? st * 32 : (st - 512) * 8, t1 = t0 + (isl ? 32 : 8);
        const float* X = (isl ? Xl : Xc) + c4; bf16* out = PM + (size_t)(isl ? NCTX : 0) * D + c4;
        const f32x4 scv = *(const f32x4*)((isl ? sc_lat : sc_ctx) + c4) + 1.f;
        f32x4 S = {0.f, 0.f, 0.f, 0.f};
        for (int tt = max(0, t0 - half); tt < min(n, t0 + half); ++tt) S += *(const f32x4*)(X + (size_t)tt * D);
        for (int tb = t0; tb < t1; tb += 8) {
            f32x4 xa[8], xp[8], xm[8];
#pragma unroll
            for (int i = 0; i < 8; ++i) { const int t = tb + i;
                xa[i] = *(const f32x4*)(X + (size_t)t * D);
                xp[i] = *(const f32x4*)(X + (size_t)min(t + half, n - 1) * D) * ((t + half < n) ? 1.f : 0.f);
                xm[i] = *(const f32x4*)(X + (size_t)max(t - half, 0) * D) * ((t - half >= 0) ? 1.f : 0.f); }
#pragma unroll
            for (int i = 0; i < 8; ++i) { const int t = tb + i;
                const int lo = max(0, t - half), hi = min(n, t + half);
                const f32x4 m = (S * (1.f / (float)(hi - lo)) - xa[i]) * scv;
                *(u32x2*)(out + (size_t)t * D) = (u32x2){cvtpk(m[0], m[1]), cvtpk(m[2], m[3])};
                S += xp[i]; S -= xm[i]; }
        }
    }
}
__device__ __forceinline__ void gather_pass(Frame& F0, const unsigned* cnt, const int* listTok, const bf16* H, bf16* AP, const float* hsc, float* hscm) {
    Frame F = F0; { int t = threadIdx.x; asm volatile("" : "+v"(t)); F.tid = t; F.lane = t & 63; F.wave = __builtin_amdgcn_readfirstlane(t >> 6); }
    int ne[8], pb[8], p = 0;
#pragma unroll
    for (int e = 0; e < 8; ++e) { ne[e] = (int)__hip_atomic_load(cnt + 64 * e, __ATOMIC_RELAXED, __HIP_MEMORY_SCOPE_AGENT); pb[e] = p; p += (ne[e] + 255) >> 8; }
    const int total = p * 256, gw = F.vcu * NWAVES + F.wave, NGW = F.G * NWAVES;
    for (int s0 = gw * 4; s0 < total; s0 += NGW * 4) {
        int tok[4];
#pragma unroll
        for (int i = 0; i < 4; ++i) { const int s = s0 + i; int es = 0, ps = 0, ns = 0;
#pragma unroll
            for (int e = 0; e < 8; ++e) if (s >= pb[e] * 256) { es = e; ps = s - pb[e] * 256; ns = ne[e]; }
            tok[i] = (ps < ns) ? listTok[(size_t)es * NTOK + ps] : -1; }
        u32x4 a[4]; float hs[4];
#pragma unroll
        for (int i = 0; i < 4; ++i) { const int tk = max(tok[i], 0); a[i] = ((const u32x4*)((const unsigned char*)H + (size_t)tk * D))[F.lane]; hs[i] = hsc[tk]; }
#pragma unroll
        for (int i = 0; i < 4; ++i) { const bool v = tok[i] >= 0; const u32x4 z = {0u, 0u, 0u, 0u};
            ((u32x4*)((unsigned char*)AP + (size_t)(s0 + i) * D))[F.lane] = v ? a[i] : z; if (F.lane == 0) hscm[s0 + i] = v ? hs[i] : 0.f; }
    }
}

constexpr int PH_PRO = 0, PH_INIT = 1, PH_BASE = 2, PH_PER_J = 15, PH_TOTAL = PH_BASE + 2 * PH_PER_J;

__global__ void __launch_bounds__(NTHREADS, 2) trunk_fwd(Args args) {
    extern __shared__ __attribute__((aligned(16))) unsigned char lds[];
    Frame F;
    F.lds = (LAS unsigned char*)lds; F.tid = threadIdx.x; F.lane = F.tid & 63; F.wave = __builtin_amdgcn_readfirstlane(F.tid >> 6);
    F.G = gridDim.x; { const int bx = blockIdx.x; F.vcu = (F.G % 8 == 0) ? (bx % 8) * (F.G / 8) + bx / 8 : bx; }
    F.ws = args.ws; F.in = args.in; F.out = args.out;
    unsigned* ctl = (unsigned*)(F.ws + WS_CTL);
    for (int u = F.tid; u < (LDS_BYTES - LDSCTL_OFF) / 4; u += NTHREADS) ((LAS unsigned*)(F.lds + LDSCTL_OFF))[u] = 0u;
    __syncthreads();
    const int lo = args.ph_lo, hi = args.ph_hi;
    const bool multi = (hi - lo) > 1;
    XcdBarrier bar; bar.bar = ctl + CW_BAR; bar.x = 0; bar.st = nullptr;
    if (multi) bar = xcd_barrier_post(ctl + CW_BAR, (volatile LAS unsigned*)(F.lds + MISC_OFF) + 8);
#define IN(k) (lo <= (k) && (k) < hi)
#define SEAM(k) do { if (IN(k) && IN((k) + 1)) xcd_barrier(bar); } while (0)
#define W_ring (F.lds + RING_OFF)
#define W_Xl (F.out)
#define W_Xc ((float*)(F.ws + WS_XC))
#define W_H ((bf16*)(F.ws + WS_H))
#define W_OB ((bf16*)(F.ws + WS_OB))
#define W_PROJ ((bf16*)(F.ws + WS_PROJ))
#define W_QM ((bf16*)(F.ws + WS_QM))
#define W_KM ((bf16*)(F.ws + WS_KM))
#define W_VM ((bf16*)(F.ws + WS_VM))
#define W_HID ((bf16*)(F.ws + WS_HID))
#define W_HIDM ((bf16*)(F.ws + WS_HIDM))
#define W_AP ((bf16*)(F.ws + WS_APERM))
#define W_SSQ ((float*)(F.ws + WS_SSQ))
#define W_rope ((const float*)(F.ws + WS_ROPE))
#define W_rowslot ((int*)(F.ws + WS_ROWSLOT))
#define W_listTok ((int*)(F.ws + WS_LISTTOK))
#define W_listW ((float*)(F.ws + WS_LISTW))

    if (EN(0) && IN(PH_PRO)) { p0_prologue(F); } SEAM(PH_PRO);
    if (EN(1) && IN(PH_INIT)) {
        RowPass P{}; P.src_lat = F.in[I_X]; P.src_ctx = F.in[I_CTX]; P.dst_lat = W_Xl; P.dst_ctx = W_Xc; P.do_ctx = true; P.skip_lat_store = true;
        P.sh_lat = modv(F, 0, 0, 0); P.sc_lat = modv(F, 0, 0, 1); P.sh_ctx = modv(F, 0, 1, 0); P.sc_ctx = modv(F, 0, 1, 1); P.write_h = true; P.hi8 = true; P.hsc = (float*)(F.ws + WS_HSC); P.H = W_H;
        row_pass<false, false, false>(F, P);
    } SEAM(PH_INIT);

    for (int j = 0; j < 2; ++j) {
        const int pe = PH_BASE + j * PH_PER_J, le = 2 * j, lod = 2 * j + 1;
        const bool ctx_e = (j == 0);
        const bool ctx_o = (j == 0);
        if (EN(2) && IN(pe + 0)) {
            pg8::DenseOrder S; S.init(65, 8, 0, F.G, (int)blockIdx.x, W_H, (size_t)256 * D, 0, F.ws + WS_WIN + (size_t)j * 2048 * 1024, (size_t)256 * 1024);
            pg8::EpiProj E{W_PROJ, W_SSQ, W_KM, W_rope, (float*)(F.ws + WS_KMAXP) + j * 33 * 130, (const float*)(F.ws + WS_HSC), (const float*)(F.ws + WS_WSCI) + j * 2048};
            pg8::gemm_phase<pg8::EpiProj, pg8::DenseOrder, 2>(W_ring, 512, 512, 512, S, E);
        } SEAM(pe + 0);
        if (EN(3) && IN(pe + 1)) {
            pg8::DenseOrder S; S.init(65, 7, 0, F.G, (int)blockIdx.x, W_PROJ + 1536, (size_t)256 * PROJ_LD * 2, 0, (const bf16*)(F.ws + WS_WUP + (size_t)j * 3 * MiB / 2), (size_t)256 * UP_K * 2);
            pg8::EpiUp E{W_SSQ, W_QM, W_KM, W_VM, W_rope, (float*)(F.ws + WS_KMAXP) + j * 33 * 130};
            pg8::gemm_phase(W_ring, UP_K, PROJ_LD, UP_K, S, E);
        } SEAM(pe + 1);
        if (EN(4) && IN(pe + 2)) {
            const int U = 1024 + (ctx_e ? 16 : 0);
            const float* relb = F.in[I_RELB] + (size_t)j * 8 * 465;
            for (int id = F.vcu; id < U; id += F.G) {
                const bool isctx = id >= 1024; const int x = id - 1024;
                const bool mla = isctx ? (x < 8) : (id < 512);
                const int id2 = id & 511, rem = id2 & 255;
                const int head = isctx ? (x & 7) : (rem >> 5), qb = (rem & 31) + 32 * (id2 >> 8);
                const size_t qrow = isctx ? 0 : (size_t)(NCTX + qb * 256);
                if (mla) {
                    const float* km = (const float*)(F.ws + WS_KMAXP) + j * 33 * 130;
                    const float k2 = kmax_q(km, 0, F.lane) + kmax_q(km, 1 + head * 2, F.lane) + kmax_q(km, 2 + head * 2, F.lane);
                    mla::attn_unit<96, false, QM_LD, KM_LD, VM_LD, D>(W_QM + qrow * QM_LD + head * 96, W_KM + head * 96, W_VM + head * 64, W_OB + qrow * D + 512 + head * 64, isctx ? 4 : NTOK / 64, k2, 0, 0, nullptr, (LAS char*)W_ring);
                } else {
                    const int R0 = 4 * qb, krs = min(min(max(R0 - 4, 0), 248), 244);
                    const bf16* Ph = W_PROJ + head * 64;
                    const float* km = (const float*)(F.ws + WS_KMAXP) + j * 33 * 130;
                    const float k2 = kmax_q(km, 17 + head * 2, F.lane) + kmax_q(km, 18 + head * 2, F.lane);
                    mla::attn_unit<64, true, PROJ_LD, PROJ_LD, PROJ_LD, D>(Ph + qrow * PROJ_LD, Ph + 512, Ph + 1024, W_OB + qrow * D + head * 64, isctx ? 4 : 16, k2, krs, R0, relb + head * 465, (LAS char*)W_ring);
                }
            }
        } SEAM(pe + 2);
        if (EN(5) && IN(pe + 3)) {
            pg8::DenseOrder S; S.init(64, 4, 1, F.G, (int)blockIdx.x, W_OB, (size_t)256 * D * 2, 0, (const bf16*)(F.ws + WS_WOUT) + (size_t)j * D * D, (size_t)256 * D * 2);
            pg8::EpiResid E{W_Xl, W_Xc, modv(F, le, 0, 2), modv(F, le, 1, 2), j == 0 ? F.in[I_X] : (const float*)W_Xl};
            pg8::gemm_phase(W_ring, 1024, 1024, 1024, S, E);
            if (ctx_e) ctx_gemm_resid<false, 1024>(F, W_OB, D, 0, (const bf16*)(F.ws + WS_WOUT) + (size_t)j * D * D, D, W_Xc, modv(F, le, 1, 2));
        } SEAM(pe + 3);
        if (EN(6) && IN(pe + 4)) {
            RowPass P{}; P.src_lat = W_Xl; P.src_ctx = W_Xc; P.dst_lat = W_Xl; P.dst_ctx = W_Xc; P.do_ctx = ctx_e; P.ln_g = F.in[I_LN1G] + le * D; P.ln_b = F.in[I_LN1B] + le * D;
            P.sh_lat = modv(F, le, 0, 3); P.sc_lat = modv(F, le, 0, 4); P.sh_ctx = modv(F, le, 1, 3); P.sc_ctx = modv(F, le, 1, 4); P.write_h = true; P.hi8 = true; P.hsc = (float*)(F.ws + WS_HSC); P.H = W_H;
            row_pass<true, false, false>(F, P);
        } SEAM(pe + 4);
        if (EN(7) && IN(pe + 5)) {
            pg8::DenseOrder S; S.init(ctx_e ? 65 : 64, 22, ctx_e ? 0 : 1, F.G, (int)blockIdx.x, W_H, (size_t)256 * D, 0, F.ws + WS_WGU + (size_t)j * 5632 * 1024, (size_t)256 * 1024);
            pg8::EpiSwigluI8 E{W_HID, FFN, (const float*)(F.ws + WS_HSC), (const float*)(F.ws + WS_WSC) + j * 5632, 0, true};
            pg8::gemm_phase<pg8::EpiSwigluI8, pg8::DenseOrder, 2>(W_ring, 512, 512, 512, S, E);
        } SEAM(pe + 5);
        if (EN(8) && IN(pe + 6)) {
            pg8::DenseOrder S; S.init(64, 4, 1, F.G, (int)blockIdx.x, W_HID, (size_t)256 * FFN, 0, F.ws + WS_WDN + (size_t)j * 11 * MiB / 2, (size_t)256 * FFN);
            pg8::EpiResid E{W_Xl, W_Xc, modv(F, le, 0, 5), modv(F, le, 1, 5), W_Xl, W8_INV};
            pg8::gemm_phase<pg8::EpiResid, pg8::DenseOrder, 1>(W_ring, FFN / 2, FFN / 2, FFN / 2, S, E);
            if (ctx_e) ctx_gemm_resid<true, FFN>(F, W_HID, FFN, 0, F.ws + WS_WDN + (size_t)j * 11 * MiB / 2, FFN, W_Xc, modv(F, le, 1, 5), W8_INV);
        } SEAM(pe + 6);
        if (EN(9) && IN(pe + 7)) {
            RowPass P{}; P.src_lat = W_Xl; P.src_ctx = W_Xc; P.dst_lat = W_Xl; P.dst_ctx = W_Xc; P.do_ctx = ctx_e; P.ln_g = F.in[I_LN2G] + le * D; P.ln_b = F.in[I_LN2B] + le * D; P.write_h = false;
            row_pass<true, false, false>(F, P);
        } SEAM(pe + 7);
        if (EN(10) && IN(pe + 8)) { pool_pass(F, W_Xl, W_Xc, ctx_o, modv(F, lod, 0, 1), modv(F, lod, 1, 1), W_OB); } SEAM(pe + 8);
        if (EN(11) && IN(pe + 9)) {
            pg8::DenseOrder S; S.init(64, 4, 1, F.G, (int)blockIdx.x, W_OB, (size_t)256 * D * 2, (size_t)256 * 2, (const bf16*)(F.ws + WS_WPOOL) + (size_t)j * 4 * 65536, (size_t)65536 * 2);
            pg8::EpiResid E{W_Xl, W_Xc, modv(F, lod, 0, 2), modv(F, lod, 1, 2), W_Xl};
            pg8::gemm_phase(W_ring, 256, 1024, 256, S, E);
            if (ctx_o) ctx_gemm_resid<false, 256>(F, W_OB, D, 256, (const bf16*)(F.ws + WS_WPOOL) + (size_t)j * 4 * 65536, 256, W_Xc, modv(F, lod, 1, 2));
        } SEAM(pe + 9);
        if (EN(12) && IN(pe + 10)) {
            RowPass P{}; P.src_lat = W_Xl; P.src_ctx = W_Xc; P.dst_lat = W_Xl; P.dst_ctx = W_Xc; P.do_ctx = ctx_o; P.ln_g = F.in[I_LN1G] + lod * D; P.ln_b = F.in[I_LN1B] + lod * D;
            P.sh_lat = modv(F, lod, 0, 3); P.sc_lat = modv(F, lod, 0, 4); P.sh_ctx = modv(F, lod, 1, 3); P.sc_ctx = modv(F, lod, 1, 4); P.write_h = true; P.hi8 = true; P.hsc = (float*)(F.ws + WS_HSC); P.H = W_H;
            P.router = F.in[I_ROUTER] + (size_t)j * D * 8; P.rowslot_w = W_rowslot; P.listTok = W_listTok; P.listW = W_listW; P.cnt_w = ctl + CW_CNT + j * 8 * 64;
            row_pass<true, false, true>(F, P);
        } SEAM(pe + 10);
        if (EN(13) && IN(pe + 11)) { gather_pass(F, ctl + CW_CNT + j * 8 * 64, W_listTok, W_H, W_AP, (const float*)(F.ws + WS_HSC), (float*)(F.ws + WS_HSCM)); } SEAM(pe + 11);
        if (EN(14) && IN(pe + 12)) {
            pg8::MoeOrder S; S.init(ctl + CW_CNT + j * 8 * 64, 28, F.G, F.vcu, W_AP, (size_t)256 * D, F.ws + WS_MGU + (size_t)j * 8 * 7 * MiB, (size_t)7 * MiB, (size_t)256 * 1024, 28, 0);
            pg8::EpiSwigluI8 E{W_HIDM, EDIM, (const float*)(F.ws + WS_HSCM), (const float*)(F.ws + WS_WSCM) + (size_t)j * 8 * 7168, 7168, true};
            pg8::gemm_phase<pg8::EpiSwigluI8, pg8::MoeOrder, 2>(W_ring, 512, 512, 512, S, E);
        } SEAM(pe + 12);
        if (EN(15) && IN(pe + 13)) {
            pg8::MoeOrder S; S.init(ctl + CW_CNT + j * 8 * 64, 8, F.G, F.vcu, W_HIDM, (size_t)256 * EDIM, F.ws + WS_MDN + (size_t)j * 8 * 7 * MiB, (size_t)7 * MiB, (size_t)256 * EDIM, 4, (size_t)(EDIM / 2));
            pg8::EpiMoeDown E{W_AP, (bf16*)(F.ws + WS_OUT2), W_listW, W8_INV};
            pg8::gemm_phase<pg8::EpiMoeDown, pg8::MoeOrder, 1>(W_ring, EDIM / 4, EDIM / 2, EDIM / 2, S, E);
        } SEAM(pe + 13);
        if (EN(16) && IN(pe + 14)) {
            RowPass P{}; P.src_lat = W_Xl; P.src_ctx = W_Xc; P.dst_lat = W_Xl; P.dst_ctx = W_Xc; P.do_ctx = ctx_o; P.ln_g = F.in[I_LN2G] + lod * D; P.ln_b = F.in[I_LN2B] + lod * D;
            P.write_h = (j == 0); if (j == 0) { P.sh_lat = modv(F, 2, 0, 0); P.sc_lat = modv(F, 2, 0, 1); P.sh_ctx = modv(F, 2, 1, 0); P.sc_ctx = modv(F, 2, 1, 1); } P.hi8 = true; P.hsc = (float*)(F.ws + WS_HSC); P.H = W_H;
            P.g2_lat = modv(F, lod, 0, 5); P.g2_ctx = modv(F, lod, 1, 5); P.OUTm = W_AP; P.OUTm2 = (const bf16*)(F.ws + WS_OUT2); P.rowslot = W_rowslot; P.cnt = ctl + CW_CNT + j * 8 * 64;
            row_pass<true, true, false>(F, P);
        } SEAM(pe + 14);
    }
#if PROBE_PHASE == 40
    if (IN(40)) {
        for (int id = F.vcu; id < 512; id += F.G) { const int rem = id & 255, head = rem >> 5, qb = (rem & 31) + 32 * (id >> 8); const size_t qrow = (size_t)(NCTX + qb * 256);
            mla::attn_unit<96, false, QM_LD, KM_LD, VM_LD, D>(W_QM + qrow * QM_LD + head * 96, W_KM + head * 96, W_VM + head * 64, W_OB + qrow * D + 512 + head * 64, NTOK / 64, 200.f, 0, 0, nullptr, (LAS char*)W_ring); } }
#endif
#if PROBE_PHASE == 41
    if (IN(41)) {
        const float* relb = F.in[I_RELB] + (size_t)8 * 465;
        for (int id = F.vcu; id < 512; id += F.G) { const int rem = id & 255, head = rem >> 5, qb = (rem & 31) + 32 * (id >> 8); const size_t qrow = (size_t)(NCTX + qb * 256);
            const int R0 = 4 * qb, krs = min(min(max(R0 - 4, 0), 248), 244); const bf16* Ph = W_PROJ + head * 64;
            mla::attn_unit<64, true, PROJ_LD, PROJ_LD, PROJ_LD, D>(Ph + qrow * PROJ_LD, Ph + 512, Ph + 1024, W_OB + qrow * D + head * 64, 16, 150.f, krs, R0, relb + head * 465, (LAS char*)W_ring); } }
#endif
#if PROBE_PHASE == 42
    if (IN(42)) {
        RowPass P{}; P.src_lat = W_Xl; P.src_ctx = W_Xc; P.dst_lat = (float*)(F.ws + WS_HIDM); P.dst_ctx = (float*)(F.ws + WS_HIDM) + (size_t)NLAT * D; P.do_ctx = true; P.ln_g = F.in[I_LN1G]; P.ln_b = F.in[I_LN1B];
        P.sh_lat = modv(F, 0, 0, 3); P.sc_lat = modv(F, 0, 0, 4); P.sh_ctx = modv(F, 0, 1, 3); P.sc_ctx = modv(F, 0, 1, 4); P.write_h = true; P.H = (bf16*)(F.ws + WS_HIDM + 80 * MiB);
        row_pass<true, false, false>(F, P); }
#endif
#if PROBE_PHASE == 43
    if (IN(43)) {
        RowPass P{}; P.src_lat = W_Xl; P.src_ctx = W_Xc; P.dst_lat = (float*)(F.ws + WS_HIDM); P.dst_ctx = (float*)(F.ws + WS_HIDM) + (size_t)NLAT * D; P.do_ctx = false; P.ln_g = F.in[I_LN2G]; P.ln_b = F.in[I_LN2B];
        P.write_h = false; P.g2_lat = modv(F, 3, 0, 5); P.g2_ctx = modv(F, 3, 1, 5); P.OUTm = W_AP; P.OUTm2 = (const bf16*)(F.ws + WS_OUT2); P.rowslot = W_rowslot; P.cnt = ctl + CW_CNT + 8 * 64;
        row_pass<true, true, false>(F, P); }
#endif
#if PROBE_PHASE == 45
    if (IN(45)) {
        RowPass P{}; P.src_lat = W_Xl; P.src_ctx = W_Xc; P.dst_lat = (float*)(F.ws + WS_HIDM); P.dst_ctx = (float*)(F.ws + WS_HIDM) + (size_t)NLAT * D; P.do_ctx = true; P.ln_g = F.in[I_LN1G]; P.ln_b = F.in[I_LN1B];
        P.sh_lat = modv(F, 1, 0, 3); P.sc_lat = modv(F, 1, 0, 4); P.sh_ctx = modv(F, 1, 1, 3); P.sc_ctx = modv(F, 1, 1, 4); P.write_h = true; P.h8 = true; P.H = (bf16*)(F.ws + WS_HIDM + 80 * MiB);
        P.router = F.in[I_ROUTER]; P.rowslot_w = (int*)(F.ws + WS_HIDM + 120 * MiB); P.listTok = (int*)(F.ws + WS_HIDM + 122 * MiB); P.listW = (float*)(F.ws + WS_HIDM + 124 * MiB); P.cnt_w = ctl + CW_CNT + 16 * 64;
        row_pass<true, false, true>(F, P); }
#endif
#if PROBE_PHASE == 46
    if (IN(46)) {
        pg8::DenseOrder S; S.init(64, 4, 1, F.G, (int)blockIdx.x, W_HID, (size_t)256 * FFN, 0, F.ws + WS_WDN, (size_t)256 * FFN);
        pg8::EpiResid E{(float*)(F.ws + WS_HIDM), (float*)(F.ws + WS_HIDM) + (size_t)NLAT * D, modv(F, 2, 0, 5), modv(F, 2, 1, 5), (const float*)(F.ws + WS_HIDM), W8_INV};
        pg8::gemm_phase<pg8::EpiResid, pg8::DenseOrder, 1>(W_ring, FFN / 2, FFN / 2, FFN / 2, S, E); }
#endif
#if PROBE_PHASE == 47
    if (IN(47)) {
        pg8::DenseOrder S; S.init(64, 4, 1, F.G, (int)blockIdx.x, W_OB, (size_t)256 * D * 2, 0, (const bf16*)(F.ws + WS_WOUT), (size_t)256 * D * 2);
        pg8::EpiResid E{(float*)(F.ws + WS_HIDM), (float*)(F.ws + WS_HIDM) + (size_t)NLAT * D, modv(F, 2, 0, 2), modv(F, 2, 1, 2), (const float*)(F.ws + WS_HIDM)};
        pg8::gemm_phase(W_ring, 1024, 1024, 1024, S, E); }
#endif
#if PROBE_PHASE == 48
    if (IN(48)) {
        pg8::DenseOrder S; S.init(64, 4, 1, F.G, (int)blockIdx.x, W_OB, (size_t)256 * D * 2, (size_t)256 * 2, (const bf16*)(F.ws + WS_WPOOL), (size_t)65536 * 2);
        pg8::EpiResid E{(float*)(F.ws + WS_HIDM), (float*)(F.ws + WS_HIDM) + (size_t)NLAT * D, modv(F, 3, 0, 2), modv(F, 3, 1, 2), (const float*)(F.ws + WS_HIDM)};
        pg8::gemm_phase(W_ring, 256, 1024, 256, S, E); }
#endif
#if PROBE_PHASE == 50
    _Pragma("clang loop unroll(disable)") for (int q = 50; q < 60; ++q) { SEAM(q); }
#endif
#if 0
#endif
#undef IN
#undef SEAM
}

extern "C" void kernel_launch(void* const* d_in, const int* in_sizes, int n_in, void* d_out, int out_size, void* d_ws, size_t ws_size, hipStream_t stream) {
    static int grid = 0;
    if (grid == 0) {
        if (n_in != 26 || out_size != NLAT * D || ws_size < WS_END) { fprintf(stderr, "kernel_launch: unexpected shapes: n_in %d out %d ws %zu (need %zu)\n", n_in, out_size, ws_size, (size_t)WS_END); grid = -1; return; }
        int dev = 0, cus = 0;
        if (hipGetDevice(&dev) != hipSuccess || hipDeviceGetAttribute(&cus, hipDeviceAttributeMultiprocessorCount, dev) != hipSuccess) { grid = -1; return; }
        if (hipFuncSetAttribute((const void*)trunk_fwd, hipFuncAttributeMaxDynamicSharedMemorySize, LDS_BYTES) != hipSuccess) { fprintf(stderr, "kernel_launch: hipFuncSetAttribute failed\n"); grid = -1; return; }
        (void)hipGetLastError();
        grid = cus;
    }
    if (grid < 0) return;
    if (hipMemsetAsync((char*)d_ws + WS_CTL, 0, CTL_ZERO_BYTES, stream) != hipSuccess) return;
    Args a{};
    for (int i = 0; i < 26; ++i) a.in[i] = (const float*)d_in[i];
    a.out = (float*)d_out; a.ws = (unsigned char*)d_ws;
#if ONE_LAUNCH
    a.ph_lo = 0; a.ph_hi = PH_TOTAL;
    hipLaunchKernelGGL(trunk_fwd, dim3(grid), dim3(NTHREADS), LDS_BYTES, stream, a);
    if (PROBE_PHASE >= 0) { (void)hipMemsetAsync((char*)d_ws + WS_CTL + CW_BAR * 4, 0, XCD_BAR_WORDS * 4, stream); a.ph_lo = PROBE_PHASE; a.ph_hi = PROBE_HI; hipLaunchKernelGGL(trunk_fwd, dim3(grid), dim3(NTHREADS), LDS_BYTES, stream, a); }
#else
    for (int p = 0; p < PH_TOTAL; ++p) { a.ph_lo = p; a.ph_hi = p + 1; hipLaunchKernelGGL(trunk_fwd, dim3(grid), dim3(NTHREADS), LDS_BYTES, stream, a); }
#endif
}
```
